# Optimizing an MI355X kernel written in HIP

```python
import jax, jax.numpy as jnp
from jax import lax
import numpy as np

D_MODEL = 2048
BATCH = 4
SEQ = 2048
DEPTH = 1
DEC_BATCH = 8
DEC_SEQ = 8
PAST_LEN = 16384
PAGE_SIZE = 128

N_HEADS_A = 8
HEAD_DIM = 128
D_ATTN = N_HEADS_A * HEAD_DIM
D_CONV = D_MODEL - D_ATTN
CONV_WIDTH = 31
DILATED_PATTERNS = ((128, 1), (512, 4), (2048, 16))
MAX_WINDOW = max(w for w, _ in DILATED_PATTERNS)
BAND_BLOCK = 128
D_FF = 4 * D_MODEL
D_IN = 3 * D_ATTN + 2 * D_CONV
LN_EPS = 1e-5
DN_ALPHA = (2 * DEPTH) ** 0.25
DN_BETA = (8 * DEPTH) ** -0.25
ATTN_SCALE = HEAD_DIM ** -0.5

kernel_name = 'hymba_dilated_attn_conformer_conv_decode_step'


def layer_norm(x, g, b):
    xf = x.astype(jnp.float32)
    mu = jnp.mean(xf, axis=-1, keepdims=True)
    var = jnp.mean(jnp.square(xf - mu), axis=-1, keepdims=True)
    y = (xf - mu) * lax.rsqrt(var + LN_EPS) * g.astype(jnp.float32) + b.astype(jnp.float32)
    return y.astype(x.dtype)


def split_proj(x, w_in):
    p = jnp.einsum('ntd,de->nte', x, w_in)
    q, k, v, a, g = jnp.split(p, [D_ATTN, 2 * D_ATTN, 3 * D_ATTN, 3 * D_ATTN + D_CONV], axis=-1)
    heads = lambda t: t.reshape(t.shape[0], t.shape[1], N_HEADS_A, HEAD_DIM)
    return heads(q), heads(k), heads(v), a * jax.nn.sigmoid(g)


def dilated_band_attention(q, k, v, dil, band):
    B, S, H, Dh = q.shape
    L = S // dil
    nb = -(-L // BAND_BLOCK)
    Lp = nb * BAND_BLOCK

    def residues(t):
        t = t.reshape(B, L, dil, H, Dh).transpose(0, 2, 1, 3, 4)
        t = jnp.pad(t, ((0, 0), (0, 0), (0, Lp - L), (0, 0), (0, 0)))
        return t.reshape(B, dil, nb, BAND_BLOCK, H, Dh)

    def with_prev(t):
        prev = jnp.pad(t[:, :, :-1], ((0, 0), (0, 0), (1, 0), (0, 0), (0, 0), (0, 0)))
        return jnp.concatenate([prev, t], axis=3)

    qb = residues(q).astype(jnp.float32)
    kk = with_prev(residues(k)).astype(jnp.float32)
    vv = with_prev(residues(v)).astype(jnp.float32)
    s = jnp.einsum('brnqhd,brnkhd->brnhqk', qb, kk) * ATTN_SCALE
    qi = jnp.arange(BAND_BLOCK)[:, None]
    ki = jnp.arange(2 * BAND_BLOCK)[None, :]
    delta = BAND_BLOCK + qi - ki
    kpos = jnp.arange(nb)[:, None, None] * BAND_BLOCK - BAND_BLOCK + ki[None]
    mask = (delta >= 0) & (delta <= band) & (kpos >= 0)
    s = jnp.where(mask[:, None], s, -jnp.inf)
    lse = jax.nn.logsumexp(s, axis=-1)
    p = jnp.exp(s - lse[..., None])
    o = jnp.einsum('brnhqk,brnkhd->brnqhd', p, vv)
    o = o.reshape(B, dil, Lp, H, Dh)[:, :, :L].transpose(0, 2, 1, 3, 4).reshape(B, S, H, Dh)
    lse = lse.transpose(0, 1, 2, 4, 3).reshape(B, dil, Lp, H)[:, :, :L]
    lse = lse.transpose(0, 2, 1, 3).reshape(B, S, H)
    return o, lse


def dilated_gather_attention(q, ext_k, ext_v, dil, band, n_buf):
    T = q.shape[1]
    j = jnp.arange(band + 1)
    idx = n_buf + jnp.arange(T)[:, None] - dil * j[None, :]
    valid = idx >= 0
    idx = jnp.maximum(idx, 0)
    kg = ext_k[:, idx].astype(jnp.float32)
    vg = ext_v[:, idx].astype(jnp.float32)
    s = jnp.einsum('nthd,ntjhd->nhtj', q.astype(jnp.float32), kg) * ATTN_SCALE
    s = jnp.where(valid[None, None], s, -jnp.inf)
    lse = jax.nn.logsumexp(s, axis=-1)
    p = jnp.exp(s - lse[..., None])
    o = jnp.einsum('nhtj,ntjhd->nthd', p, vg)
    return o, lse.transpose(0, 2, 1)


def combine_patterns(outs, lses):
    w = jax.nn.softmax(jnp.stack(lses), axis=0)
    return jnp.einsum('pnth,pnthd->nthd', w, jnp.stack(outs))


def conv_tail(u_ext, w_dw, b_dw, ln_g, ln_b):
    y = lax.conv_general_dilated(u_ext, w_dw[:, None, :], window_strides=(1,), padding='VALID',
                                 dimension_numbers=('NWC', 'WIO', 'NWC'),
                                 feature_group_count=D_CONV) + b_dw
    return jax.nn.silu(layer_norm(y, ln_g, ln_b))


def block_out(x, o_attn, c, w_out, ln1_g, ln1_b, w_up, w_down, ln2_g, ln2_b):
    n, t = x.shape[0], x.shape[1]
    mixed = jnp.concatenate([o_attn.astype(x.dtype).reshape(n, t, D_ATTN), c], axis=-1)
    z = jnp.einsum('nte,ed->ntd', mixed, w_out)
    h = layer_norm(DN_ALPHA * x + z, ln1_g, ln1_b)
    f = jnp.einsum('ntf,fd->ntd', jnp.square(jax.nn.relu(jnp.einsum('ntd,df->ntf', h, w_up))), w_down)
    return layer_norm(DN_ALPHA * h + f, ln2_g, ln2_b)


def setup_inputs(seed: int = 0) -> dict:
    key = jax.random.key(seed)
    ks = jax.random.split(key, 18)
    n_buf = min(MAX_WINDOW, PAST_LEN)
    nrm = lambda k, shape, scale: jax.random.normal(k, shape, jnp.float32) * scale
    return {
        'x_prompt': nrm(ks[0], (BATCH, SEQ, D_MODEL), 1.0),
        'x_sample': nrm(ks[1], (DEC_BATCH, DEC_SEQ, D_MODEL), 1.0),
        'cache_k': nrm(ks[2], (DEPTH, DEC_BATCH, n_buf, N_HEADS_A, HEAD_DIM), 1.0),
        'cache_v': nrm(ks[3], (DEPTH, DEC_BATCH, n_buf, N_HEADS_A, HEAD_DIM), 1.0),
        'state_conv': nrm(ks[4], (DEPTH, DEC_BATCH, CONV_WIDTH - 1, D_CONV), 0.5),
        'w_in': nrm(ks[5], (DEPTH, D_MODEL, D_IN), D_MODEL ** -0.5),
        'w_dw': nrm(ks[6], (DEPTH, CONV_WIDTH, D_CONV), CONV_WIDTH ** -0.5),
        'b_dw': nrm(ks[7], (DEPTH, D_CONV), 0.02),
        'ln_conv_g': 1.0 + nrm(ks[8], (DEPTH, D_CONV), 0.02),
        'ln_conv_b': nrm(ks[9], (DEPTH, D_CONV), 0.02),
        'w_out': nrm(ks[10], (DEPTH, D_ATTN + D_CONV, D_MODEL), (D_ATTN + D_CONV) ** -0.5 * DN_BETA),
        'ln1_g': 1.0 + nrm(ks[11], (DEPTH, D_MODEL), 0.02),
        'ln1_b': nrm(ks[12], (DEPTH, D_MODEL), 0.02),
        'w_up': nrm(ks[13], (DEPTH, D_MODEL, D_FF), D_MODEL ** -0.5),
        'w_down': nrm(ks[14], (DEPTH, D_FF, D_MODEL), D_FF ** -0.5 * DN_BETA),
        'ln2_g': 1.0 + nrm(ks[15], (DEPTH, D_MODEL), 0.02),
        'ln2_b': nrm(ks[16], (DEPTH, D_MODEL), 0.02),
    }


def reference(x_prompt, x_sample, cache_k, cache_v, state_conv, w_in, w_dw, b_dw, ln_conv_g,
              ln_conv_b, w_out, ln1_g, ln1_b, w_up, w_down, ln2_g, ln2_b):
    n_buf = cache_k.shape[2]
    keep_p = min(MAX_WINDOW, x_prompt.shape[1])
    xp, xs = x_prompt, x_sample
    kp_l, vp_l, cp_l, ks_l, vs_l, cs_l = [], [], [], [], [], []
    for l in range(DEPTH):
        q, k, v, u = split_proj(xp, w_in[l])
        outs, lses = zip(*[dilated_band_attention(q, k, v, d, w // d) for w, d in DILATED_PATTERNS])
        o = combine_patterns(outs, lses)
        u_ext = jnp.pad(u, ((0, 0), (CONV_WIDTH - 1, 0), (0, 0)))
        c = conv_tail(u_ext, w_dw[l], b_dw[l], ln_conv_g[l], ln_conv_b[l])
        kp_l.append(k[:, -keep_p:])
        vp_l.append(v[:, -keep_p:])
        cp_l.append(u_ext[:, -(CONV_WIDTH - 1):])
        xp = block_out(xp, o, c, w_out[l], ln1_g[l], ln1_b[l], w_up[l], w_down[l], ln2_g[l], ln2_b[l])
        q, k, v, u = split_proj(xs, w_in[l])
        ext_k = jnp.concatenate([cache_k[l], k], axis=1)
        ext_v = jnp.concatenate([cache_v[l], v], axis=1)
        outs, lses = zip(*[dilated_gather_attention(q, ext_k, ext_v, d, w // d, n_buf)
                           for w, d in DILATED_PATTERNS])
        o = combine_patterns(outs, lses)
        u_ext = jnp.concatenate([state_conv[l], u], axis=1)
        c = conv_tail(u_ext, w_dw[l], b_dw[l], ln_conv_g[l], ln_conv_b[l])
        ks_l.append(ext_k[:, -n_buf:])
        vs_l.append(ext_v[:, -n_buf:])
        cs_l.append(u_ext[:, -(CONV_WIDTH - 1):])
        xs = block_out(xs, o, c, w_out[l], ln1_g[l], ln1_b[l], w_up[l], w_down[l], ln2_g[l], ln2_b[l])
    return (xp, xs, jnp.stack(kp_l), jnp.stack(vp_l), jnp.stack(cp_l),
            jnp.stack(ks_l), jnp.stack(vs_l), jnp.stack(cs_l))
```

```cpp
#include <hip/hip_runtime.h>
#include <hip/hip_cooperative_groups.h>
#include <cstdio>
#include <cstdint>
namespace cg = cooperative_groups;
namespace pg8 {
#define PG8_LAS __attribute__((address_space(3)))
typedef unsigned short bf16_t;
typedef short bf16x8 __attribute__((ext_vector_type(8)));
typedef float f32x4 __attribute__((ext_vector_type(4)));
typedef unsigned u32x4 __attribute__((ext_vector_type(4)));
constexpr int BM = 256, BK = 64, HALF = 128, HTB = HALF * BK * 2  , STAGE_BYTES = 8 * HTB, NXCD = 8, WGM = 8;

__host__ __device__ __forceinline__ int lds_byte(int r, int c) { const int st = (r >> 4) * 2 + (c >> 5), rr = r & 15, cc = c & 31, ob = rr * 64 + cc * 2; return st * 1024 + (ob ^ (((ob >> 9) & 1) << 5)); }
__host__ __device__ __forceinline__ void stage_rc(int b, int& R, int& C) { const int st = b / 1024, sb = b % 1024, swz = sb ^ (((sb >> 9) & 1) << 5); R = (st >> 1) * 16 + swz / 64; C = (st & 1) * 32 + (swz % 64) / 2; }
__host__ __device__ __forceinline__ int perm32(int rho) { const int n = rho >> 4, i = rho & 15; return 8 * (i >> 2) + 4 * n + (i & 3); }

struct Unit { int pm, pn; };
struct Gemm { const bf16_t* A; const bf16_t* Bt; int M, N, K; };

struct StaticOrder {
    int nM, nN, nwg, G, c;
    __host__ __device__ void init(int M, int N, int G_, int c_) { nM = M / BM; nN = N / BM; nwg = nM * nN; G = G_; c = c_; }
    __host__ __device__ bool next(int i, Unit& u) const {
        const long L = (long)i * G + c; if (L >= nwg) return false;
        int wgid = (int)L; { const int q = nwg / NXCD, r = nwg % NXCD, xcd = wgid % NXCD, off = wgid / NXCD; wgid = (xcd < r ? xcd * (q + 1) : r * (q + 1) + (xcd - r) * q) + off; }
        const int nig = WGM * nN, gid = wgid / nig, fm = gid * WGM, gsz = (nM - fm) < WGM ? (nM - fm) : WGM;
        u.pm = fm + ((wgid % nig) % gsz); u.pn = (wgid % nig) / gsz; return true;
    }
    __device__ __forceinline__ void a_ready(const Unit&) const {}
    __device__ __forceinline__ void done(const Unit&) const {}
};

__device__ __forceinline__ unsigned cvt_pk_bf16(float lo, float hi) { unsigned r; asm volatile("v_cvt_pk_bf16_f32 %0, %1, %2" : "=v"(r) : "v"(lo), "v"(hi)); return r; }
template <class Epi, class Sched, bool ALIGN_EPI = false, bool SP2 = false>
__device__ __forceinline__ void gemm_phase(PG8_LAS unsigned char* lds, const Gemm g, const Sched& S, const Epi& E) {
    const int tid = threadIdx.x, wid = __builtin_amdgcn_readfirstlane(tid >> 6), lane = tid & 63, wr = wid >> 2, wc = wid & 3, fr = lane & 15, fq = lane >> 4;
    const int K = g.K, nt = K / BK;
    unsigned voffA[2], voffB[2];
#pragma unroll
    for (int i = 0; i < 2; ++i) { int R, C; stage_rc(tid * 16 + i * 8192, R, C); const int Rb = Epi::PERM ? ((R & ~31) + perm32(R & 31)) : R;
        voffA[i] = (unsigned)(R * K + C) * 2u; voffB[i] = (unsigned)(Rb * K + C) * 2u; }
    const size_t kstep = (size_t)(BK * 2);
    const size_t hstep = (size_t)HALF * K * 2;
    const size_t tstep = 2 * hstep;
    const unsigned ldsw = (unsigned)wid * 1024u;
    const int aoff = lds_byte(wr * 64 + fr, fq * 8), boff = lds_byte(wc * 32 + fr, fq * 8);
#define PG8_SA(b, h) (((b) * 2 + (h)) * HTB)
#define PG8_SB(b, h) ((4 + (b) * 2 + (h)) * HTB)
#define PG8_STAGE(bufoff, gbase, voff) do { _Pragma("unroll") for (int _i = 0; _i < 2; ++_i) \
        __builtin_amdgcn_global_load_lds((const unsigned*)((const char*)(gbase) + (voff)[_i]), (PG8_LAS unsigned*)(lds + (bufoff) + ldsw + _i * 8192), 16, 0, 0); } while (0)
#define PG8_LDA(dst, b, h) do { _Pragma("unroll") for (int m = 0; m < 4; ++m) _Pragma("unroll") for (int k = 0; k < 2; ++k) dst[m][k] = *(const PG8_LAS bf16x8*)(lds + PG8_SA(b, h) + aoff + m * 2048 + k * 1024); } while (0)
#define PG8_LDB(dst, b, h) do { _Pragma("unroll") for (int n = 0; n < 2; ++n) _Pragma("unroll") for (int k = 0; k < 2; ++k) dst[n][k] = *(const PG8_LAS bf16x8*)(lds + PG8_SB(b, h) + boff + n * 2048 + k * 1024); } while (0)
#define PG8_MMA(ai, bj, At, Bt) do { __builtin_amdgcn_s_setprio(1); _Pragma("unroll") for (int m = 0; m < 4; ++m) _Pragma("unroll") for (int n = 0; n < 2; ++n) _Pragma("unroll") for (int k = 0; k < 2; ++k) \
        acc[ai][bj][m][n] = __builtin_amdgcn_mfma_f32_16x16x32_bf16(Bt[n][k], At[m][k], acc[ai][bj][m][n], 0, 0, 0); __builtin_amdgcn_s_setprio(0); } while (0)
#define PG8_WAIT_V(n) asm volatile("s_waitcnt vmcnt(" #n ")" ::: "memory")
#define PG8_WAIT_L(n) asm volatile("s_waitcnt lgkmcnt(" #n ")" ::: "memory")
#define PG8_BAR __builtin_amdgcn_s_barrier()
#define PG8_SCHED __builtin_amdgcn_sched_barrier(0)
    Unit cur, nxt; int ui = 0;
    if (!S.next(0, cur)) return;
    f32x4 acc[2][2][4][2];
#pragma unroll
    for (int a = 0; a < 2; ++a)
#pragma unroll
        for (int b = 0; b < 2; ++b)
#pragma unroll
            for (int m = 0; m < 4; ++m)
#pragma unroll
                for (int n = 0; n < 2; ++n) acc[a][b][m][n] = (f32x4){0.f, 0.f, 0.f, 0.f};
    bf16x8 At[4][2], B0[2][2], B1[2][2];
    const char* cA = (const char*)g.A + (size_t)cur.pm * tstep; const char* cB = (const char*)g.Bt + (size_t)cur.pn * tstep;
    S.a_ready(cur);
    if constexpr (SP2) {
        PG8_STAGE(PG8_SB(0, 0), cB, voffB); PG8_STAGE(PG8_SB(0, 1), cB + hstep, voffB); PG8_STAGE(PG8_SA(0, 0), cA, voffA); PG8_STAGE(PG8_SA(0, 1), cA + hstep, voffA);
        if (wr == 1) PG8_BAR;
        PG8_WAIT_V(2); PG8_BAR;
        PG8_STAGE(PG8_SB(1, 0), cB + kstep, voffB); PG8_STAGE(PG8_SA(1, 0), cA + kstep, voffA); PG8_STAGE(PG8_SB(1, 1), cB + hstep + kstep, voffB);
        PG8_WAIT_V(6); PG8_BAR;
    } else {
        PG8_STAGE(PG8_SB(0, 0), cB, voffB); PG8_STAGE(PG8_SA(0, 0), cA, voffA); PG8_STAGE(PG8_SB(0, 1), cB + hstep, voffB); PG8_STAGE(PG8_SA(0, 1), cA + hstep, voffA);
        if (wr == 1) PG8_BAR;
        PG8_WAIT_V(4); PG8_BAR;
        PG8_STAGE(PG8_SB(1, 0), cB + kstep, voffB); PG8_STAGE(PG8_SA(1, 0), cA + kstep, voffA); PG8_STAGE(PG8_SB(1, 1), cB + hstep + kstep, voffB);
        PG8_WAIT_V(6); PG8_BAR;
    }
    for (;;) {
        const bool has_next = S.next(ui + 1, nxt);
        const char* nA = has_next ? (const char*)g.A + (size_t)nxt.pm * tstep : cA; const char* nB = has_next ? (const char*)g.Bt + (size_t)nxt.pn * tstep : cB;
        for (int t = 0; t < nt; t += 2) {
            const bool last = (t == nt - 2);
            const char* a1 = cA + (size_t)(t + 1) * kstep;
            const char* a2 = last ? nA : cA + (size_t)(t + 2) * kstep; const char* b2 = last ? nB : cB + (size_t)(t + 2) * kstep;
            const char* a3 = a2 + kstep; const char* b3 = b2 + kstep;
            if (last && has_next) S.a_ready(nxt);
            if constexpr (SP2) {
            PG8_LDB(B0, 0, 0); PG8_LDB(B1, 0, 1); PG8_SCHED; PG8_LDA(At, 0, 0); PG8_STAGE(PG8_SA(1, 1), a1 + hstep, voffA);
            PG8_WAIT_V(8); PG8_WAIT_L(0); PG8_BAR; PG8_MMA(0, 0, At, B0); PG8_MMA(0, 1, At, B1); PG8_BAR; PG8_SCHED;
            PG8_LDA(At, 0, 1); PG8_STAGE(PG8_SB(0, 0), b2, voffB); PG8_STAGE(PG8_SB(0, 1), b2 + hstep, voffB); PG8_STAGE(PG8_SA(0, 0), a2, voffA);
            PG8_WAIT_V(8); PG8_WAIT_L(0); PG8_BAR; PG8_MMA(1, 0, At, B0); PG8_MMA(1, 1, At, B1); PG8_BAR; PG8_SCHED;
            PG8_LDB(B0, 1, 0); PG8_LDB(B1, 1, 1); PG8_SCHED; PG8_LDA(At, 1, 0); PG8_STAGE(PG8_SA(0, 1), a2 + hstep, voffA);
            PG8_WAIT_V(8); PG8_WAIT_L(0); PG8_BAR; PG8_MMA(0, 0, At, B0); PG8_MMA(0, 1, At, B1); PG8_BAR; PG8_SCHED;
            PG8_LDA(At, 1, 1); PG8_STAGE(PG8_SB(1, 0), b3, voffB); PG8_STAGE(PG8_SB(1, 1), b3 + hstep, voffB); PG8_STAGE(PG8_SA(1, 0), a3, voffA);
            PG8_WAIT_V(8); PG8_WAIT_L(0); PG8_BAR; PG8_MMA(1, 0, At, B0); PG8_MMA(1, 1, At, B1); PG8_BAR; PG8_SCHED;
            } else {
            PG8_LDB(B0, 0, 0); PG8_SCHED; PG8_LDA(At, 0, 0); PG8_STAGE(PG8_SA(1, 1), a1 + hstep, voffA);
            PG8_WAIT_L(8); PG8_BAR; PG8_WAIT_L(0); PG8_MMA(0, 0, At, B0); PG8_BAR; PG8_SCHED;
            PG8_LDB(B1, 0, 1); PG8_STAGE(PG8_SB(0, 0), b2, voffB);
            PG8_BAR; PG8_WAIT_L(0); PG8_MMA(0, 1, At, B1); PG8_BAR;
            PG8_LDA(At, 0, 1); PG8_STAGE(PG8_SA(0, 0), a2, voffA);
            PG8_BAR; PG8_WAIT_L(0); PG8_MMA(1, 0, At, B0); PG8_BAR; PG8_SCHED;
            PG8_STAGE(PG8_SB(0, 1), b2 + hstep, voffB);
            PG8_WAIT_V(6); PG8_BAR; PG8_MMA(1, 1, At, B1); PG8_BAR;
            PG8_LDB(B0, 1, 0); PG8_SCHED; PG8_LDA(At, 1, 0); PG8_STAGE(PG8_SA(0, 1), a2 + hstep, voffA);
            PG8_WAIT_L(8); PG8_BAR; PG8_WAIT_L(0); PG8_MMA(0, 0, At, B0); PG8_BAR; PG8_SCHED;
            PG8_LDB(B1, 1, 1); PG8_STAGE(PG8_SB(1, 0), b3, voffB);
            PG8_BAR; PG8_WAIT_L(0); PG8_MMA(0, 1, At, B1); PG8_BAR;
            PG8_LDA(At, 1, 1); PG8_STAGE(PG8_SA(1, 0), a3, voffA);
            PG8_BAR; PG8_WAIT_L(0); PG8_MMA(1, 0, At, B0); PG8_BAR; PG8_SCHED;
            PG8_STAGE(PG8_SB(1, 1), b3 + hstep, voffB);
            PG8_WAIT_V(6); PG8_BAR; PG8_MMA(1, 1, At, B1); PG8_BAR;
            }
        }
        if constexpr (ALIGN_EPI) { if (wr == 0) PG8_BAR; }
        if constexpr (!Epi::AFTER_DRAIN) { E(acc, cur, wr, wc, fr, fq); S.done(cur); }
        if (!has_next) break;
#pragma unroll
        for (int a = 0; a < 2; ++a)
#pragma unroll
            for (int b = 0; b < 2; ++b)
#pragma unroll
                for (int m = 0; m < 4; ++m)
#pragma unroll
                    for (int n = 0; n < 2; ++n) acc[a][b][m][n] = (f32x4){0.f, 0.f, 0.f, 0.f};
        cur = nxt; cA = nA; cB = nB; ++ui;
        if constexpr (ALIGN_EPI) { if (wr == 1) PG8_BAR; }
    }
    PG8_WAIT_V(0);
    if constexpr (!ALIGN_EPI) { if (wr == 0) PG8_BAR; }
    PG8_BAR;
    if constexpr (Epi::AFTER_DRAIN) { E.fused(acc, cur, wr, wc, fr, fq, lds, wid, lane); S.done(cur); }
#undef PG8_SA
#undef PG8_SB
#undef PG8_STAGE
#undef PG8_LDA
#undef PG8_LDB
#undef PG8_MMA
#undef PG8_WAIT_V
#undef PG8_WAIT_L
#undef PG8_BAR
#undef PG8_SCHED
}
}

#ifndef MK_N_LAUNCHES
#define MK_N_LAUNCHES 1
#endif
constexpr int N_PHASES = 9;
constexpr int DM = 2048, NBATCH = 4, SEQ = 2048, MP = NBATCH * SEQ, DB = 8, DS = 8, MS = DB * DS;
constexpr int NH = 8, HD = 128, DA = 1024, DC = 1024, DFF = 8192, DIN = 5120, NBUF = 2048;
constexpr float LN_EPS = 1e-5f;
constexpr float DN_ALPHA = 1.189207115002721f;
constexpr float SC2 = 0.08838834764831845f * 1.4426950408889634f;
constexpr float LOG2E = 1.4426950408889634f;

constexpr size_t O_YP = 0, O_YS = 16777216, O_KP = 16908288, O_VP = 25296896, O_CP = 33685504, O_KS = 33808384, O_VS = 50585600, O_CS = 67362816, O_END = 67608576;

constexpr size_t MiB = 1u << 20;
constexpr size_t WS_WIN = 2 * MiB, WS_WOUT = 22 * MiB, WS_WUP = 30 * MiB, WS_WDN = 62 * MiB;
constexpr size_t WS_T1 = 94 * MiB;
constexpr size_t WS_HB = 158 * MiB;
constexpr size_t WS_SMP = 190 * MiB;
constexpr size_t WS_XS = WS_SMP, WS_MIXS = WS_SMP + 256 * 1024, WS_HBS = WS_SMP + 512 * 1024, WS_T1S = WS_SMP + 1 * MiB, WS_PS = WS_SMP + 2 * MiB, WS_RS = WS_SMP + 4 * MiB;
constexpr size_t WS_XB = 196 * MiB;
constexpr size_t WS_QB = 228 * MiB, WS_KB = 244 * MiB, WS_VB = 260 * MiB;
constexpr size_t WS_U = 276 * MiB;
constexpr size_t WS_OP = 308 * MiB;
constexpr size_t WS_LSE = 356 * MiB;
constexpr size_t WS_R = 196 * MiB;
constexpr size_t WS_END = 357 * MiB;
static_assert(WS_VB - WS_KB == WS_KB - WS_QB, "q/k/v strides");

constexpr int LDS_BYTES = 147456;
constexpr int ATT_KOFF = 0, ATT_KSTR = 272, ATT_VOFF = 256 * 272, ATT_VSTR = 288;
static_assert(ATT_VOFF + 256 * ATT_VSTR <= LDS_BYTES, "attention LDS");

#define GAS __attribute__((address_space(1)))
#define LAS __attribute__((address_space(3)))
typedef unsigned short bf16;
typedef unsigned v4u __attribute__((ext_vector_type(4)));
typedef unsigned v2u __attribute__((ext_vector_type(2)));
typedef float f32x4 __attribute__((ext_vector_type(4)));
typedef float f32x2 __attribute__((ext_vector_type(2)));
typedef short bf16x8 __attribute__((ext_vector_type(8)));
typedef short s16x4 __attribute__((ext_vector_type(4)));
#define LDS_WAIT() asm volatile("s_waitcnt lgkmcnt(0)" ::: "memory")
using pg8::cvt_pk_bf16;

__device__ __forceinline__ float wave_sum(float v) {
#pragma unroll
    for (int o = 1; o < 64; o <<= 1) v += __shfl_xor(v, o);
    return v;
}
__device__ __forceinline__ float wave_max(float v) {
#pragma unroll
    for (int o = 1; o < 64; o <<= 1) v = fmaxf(v, __shfl_xor(v, o));
    return v;
}
__device__ __forceinline__ float fast_exp2(float x) { return __builtin_amdgcn_exp2f(x); }
__device__ __forceinline__ float sigmoidf_(float g) { return __builtin_amdgcn_rcpf(1.0f + fast_exp2(-g * LOG2E)); }
__device__ __forceinline__ float bf2f(unsigned short b) { return __uint_as_float(((unsigned)b) << 16); }

struct EpiG1 {
    static constexpr bool PERM = true, AFTER_DRAIN = false;
    bf16* QB; float* U; float* kout; float* convp;
    __device__ __forceinline__ void operator()(const f32x4 (&acc)[2][2][4][2], const pg8::Unit& u, int wr, int wc, int fr, int fq) const {
        const int row0 = u.pm * 256 + wr * 64 + fr;
        if (u.pn < 12) {
            const int t = u.pn >> 2; const int colt = (u.pn & 3) * 256 + wc * 32 + 8 * fq;
            bf16* B = QB + (size_t)t * ((WS_KB - WS_QB) / 2); float* O = kout + (size_t)(t == 2 ? 1 : 0) * (O_VP - O_KP);
#pragma unroll
            for (int ai = 0; ai < 2; ++ai)
#pragma unroll
                for (int m = 0; m < 4; ++m) { const size_t r = (size_t)(row0 + ai * 128 + m * 16);
#pragma unroll
                    for (int bj = 0; bj < 2; ++bj) { const f32x4 v0 = acc[ai][bj][m][0], v1 = acc[ai][bj][m][1]; const int c = colt + bj * 128;
                        v4u w; w.x = cvt_pk_bf16(v0[0], v0[1]); w.y = cvt_pk_bf16(v0[2], v0[3]); w.z = cvt_pk_bf16(v1[0], v1[1]); w.w = cvt_pk_bf16(v1[2], v1[3]);
                        *(v4u*)(B + r * 1024 + c) = w;
                        if (t != 0) { *(f32x4*)(O + r * 1024 + c) = v0; *(f32x4*)(O + r * 1024 + c + 4) = v1; } } }
        } else {
            const int j = u.pn - 12; const int colt = j * 128 + wc * 32 + 8 * fq;
#pragma unroll
            for (int ai = 0; ai < 2; ++ai)
#pragma unroll
                for (int m = 0; m < 4; ++m) { const int ri = row0 + ai * 128 + m * 16; const size_t r = (size_t)ri;
#pragma unroll
                    for (int n = 0; n < 2; ++n) { const f32x4 a = acc[ai][0][m][n], g = acc[ai][1][m][n]; f32x4 o;
#pragma unroll
                        for (int e = 0; e < 4; ++e) o[e] = a[e] * sigmoidf_(g[e]);
                        const int c = colt + 4 * n;
                        *(f32x4*)(U + r * 1024 + c) = o;
                        const int pos = ri & 2047;
                        if (pos >= 2018) *(f32x4*)(convp + ((size_t)((ri >> 11) * 30 + pos - 2018)) * 1024 + c) = o; } }
        }
    }
};
struct EpiRes {
    static constexpr bool PERM = false, AFTER_DRAIN = false;
    const float* base; float* out;
    __device__ __forceinline__ void operator()(const f32x4 (&acc)[2][2][4][2], const pg8::Unit& u, int wr, int wc, int fr, int fq) const {
        const int row0 = u.pm * 256 + wr * 64 + fr, col0 = u.pn * 256 + wc * 32 + 4 * fq;
#pragma unroll
        for (int ai = 0; ai < 2; ++ai)
#pragma unroll
            for (int m = 0; m < 4; ++m) { const size_t off = (size_t)(row0 + ai * 128 + m * 16) * DM + col0;
#pragma unroll
                for (int bj = 0; bj < 2; ++bj)
#pragma unroll
                    for (int n = 0; n < 2; ++n) { const f32x4 bs = *(const f32x4*)(base + off + bj * 128 + n * 16);
                        *(f32x4*)(out + off + bj * 128 + n * 16) = bs * DN_ALPHA + acc[ai][bj][m][n]; }
                asm volatile("" ::: "memory"); }
    }
};
struct EpiRelu2 {
    static constexpr bool PERM = true, AFTER_DRAIN = false;
    bf16* R;
    __device__ __forceinline__ void operator()(const f32x4 (&acc)[2][2][4][2], const pg8::Unit& u, int wr, int wc, int fr, int fq) const {
        const int row0 = u.pm * 256 + wr * 64 + fr, col0 = u.pn * 256 + wc * 32 + 8 * fq;
#pragma unroll
        for (int ai = 0; ai < 2; ++ai)
#pragma unroll
            for (int m = 0; m < 4; ++m) { bf16* rowp = R + (size_t)(row0 + ai * 128 + m * 16) * DFF + col0;
#pragma unroll
                for (int bj = 0; bj < 2; ++bj) { f32x4 v0 = acc[ai][bj][m][0], v1 = acc[ai][bj][m][1];
#pragma unroll
                    for (int e = 0; e < 4; ++e) { const float a = fmaxf(v0[e], 0.f), b = fmaxf(v1[e], 0.f); v0[e] = a * a; v1[e] = b * b; }
                    v4u w; w.x = cvt_pk_bf16(v0[0], v0[1]); w.y = cvt_pk_bf16(v0[2], v0[3]); w.z = cvt_pk_bf16(v1[0], v1[1]); w.w = cvt_pk_bf16(v1[2], v1[3]);
                    *(v4u*)(rowp + bj * 128) = w; } }
    }
};

template <class E>
__device__ __forceinline__ void skinny_phase(LAS unsigned char* lds, const bf16* A, const bf16* Bt, int N, int K, int first, int stride, const E& e) {
    const int tid = threadIdx.x, lane = tid & 63, wave = __builtin_amdgcn_readfirstlane(tid >> 6), fr = lane & 15, fq = lane >> 4;
    const int ksl = K >> 3, nks = ksl >> 5;
    LAS f32x4* red = (LAS f32x4*)lds;
    for (int task = first; task < (N >> 4); task += stride) {
        f32x4 acc[4];
#pragma unroll
        for (int m = 0; m < 4; ++m) acc[m] = (f32x4){0.f, 0.f, 0.f, 0.f};
        const bf16* bp = Bt + (size_t)(task * 16 + fr) * K + wave * ksl + fq * 8;
        const bf16* ap = A + (size_t)fr * K + wave * ksl + fq * 8;
#pragma unroll 4
        for (int ks = 0; ks < nks; ++ks) {
            const bf16x8 b = *(const bf16x8*)(bp + ks * 32);
#pragma unroll
            for (int m = 0; m < 4; ++m) { const bf16x8 a = *(const bf16x8*)(ap + (size_t)(m * 16) * K + ks * 32);
                acc[m] = __builtin_amdgcn_mfma_f32_16x16x32_bf16(a, b, acc[m], 0, 0, 0); }
        }
#pragma unroll
        for (int m = 0; m < 4; ++m) red[(wave * 4 + m) * 64 + lane] = acc[m];
        __syncthreads();
        {
            const int row = tid >> 3, cp = tid & 7; const int m = row >> 4, q = (row & 15) >> 2, j = row & 3;
            float v0 = 0.f, v1 = 0.f;
            const LAS float* rf = (const LAS float*)lds;
#pragma unroll
            for (int w = 0; w < 8; ++w) { v0 += rf[(((w * 4 + m) * 64) + q * 16 + 2 * cp) * 4 + j]; v1 += rf[(((w * 4 + m) * 64) + q * 16 + 2 * cp + 1) * 4 + j]; }
            e(row, task * 16 + 2 * cp, v0, v1);
        }
        __syncthreads();
    }
}
struct SkStore { float* out; int ld; __device__ __forceinline__ void operator()(int r, int c, float v0, float v1) const { *(f32x2*)(out + (size_t)r * ld + c) = (f32x2){v0, v1}; } };
struct SkRes { const float* base; float* out; __device__ __forceinline__ void operator()(int r, int c, float v0, float v1) const { const f32x2 b = *(const f32x2*)(base + (size_t)r * DM + c); *(f32x2*)(out + (size_t)r * DM + c) = (f32x2){b.x * DN_ALPHA + v0, b.y * DN_ALPHA + v1}; } };
struct SkRelu2 { bf16* R; __device__ __forceinline__ void operator()(int r, int c, float v0, float v1) const { const float a = fmaxf(v0, 0.f), b = fmaxf(v1, 0.f); *(unsigned*)(R + (size_t)r * DFF + c) = cvt_pk_bf16(a * a, b * b); } };

__device__ __forceinline__ void transpose_item(const float* W, int K, int N, bf16* WT, int dst_n0, LAS float* scr, int k0, int n0, int lane) {
#pragma unroll 8
    for (int i = 0; i < 32; ++i) { const int kk = 2 * i + (lane >> 5); scr[kk * 33 + (lane & 31)] = W[(size_t)(k0 + kk) * N + n0 + (lane & 31)]; }
    LDS_WAIT(); asm volatile("" ::: "memory");
    const int c = lane & 7;
#pragma unroll
    for (int j = 0; j < 4; ++j) { const int n = (lane >> 3) + 8 * j; const LAS float* s = scr + (8 * c) * 33 + n;
        v4u o; o.x = cvt_pk_bf16(s[0 * 33], s[1 * 33]); o.y = cvt_pk_bf16(s[2 * 33], s[3 * 33]); o.z = cvt_pk_bf16(s[4 * 33], s[5 * 33]); o.w = cvt_pk_bf16(s[6 * 33], s[7 * 33]);
        *(v4u*)(WT + (size_t)(dst_n0 + n) * K + k0 + 8 * c) = o; }
    LDS_WAIT(); asm volatile("" ::: "memory");
}
__device__ __forceinline__ int win_dst(int n0) {
    if (n0 < 3072) return n0;
    if (n0 < 4096) { const int c = n0 - 3072; return 3072 + (c >> 7) * 256 + (c & 127); }
    const int c = n0 - 4096; return 3072 + (c >> 7) * 256 + 128 + (c & 127);
}

template <bool WB>
__device__ __forceinline__ void ln_row(const float* in, float* out, bf16* outb, const float* g, const float* b, int lane) {
    const f32x4* xr = (const f32x4*)in + lane; f32x4 v[8]; float s = 0.f;
#pragma unroll
    for (int j = 0; j < 8; ++j) { v[j] = xr[64 * j]; s += (v[j].x + v[j].y) + (v[j].z + v[j].w); }
    const float mean = wave_sum(s) * (1.f / DM); float s2 = 0.f;
#pragma unroll
    for (int j = 0; j < 8; ++j) { v[j] = v[j] - mean; s2 += (v[j].x * v[j].x + v[j].y * v[j].y) + (v[j].z * v[j].z + v[j].w * v[j].w); }
    const float rstd = 1.f / sqrtf(wave_sum(s2) * (1.f / DM) + LN_EPS);
#pragma unroll
    for (int j = 0; j < 8; ++j) { const f32x4 gg = ((const f32x4*)g)[64 * j + lane], bb = ((const f32x4*)b)[64 * j + lane];
        const f32x4 o = v[j] * rstd * gg + bb; ((f32x4*)out)[64 * j + lane] = o;
        if (WB) { v2u w; w.x = cvt_pk_bf16(o.x, o.y); w.y = cvt_pk_bf16(o.z, o.w); ((v2u*)outb)[64 * j + lane] = w; } }
}

template <int NTOK, class LD>
__device__ __forceinline__ void conv_core(const LD& ld, const float* w_dw, const float* b_dw, const float* lg, const float* lb, bf16* mix0, LAS float* red, int tid, int lane, int wave) {
    const int c = tid * 2;
    f32x2 w[31];
#pragma unroll
    for (int j = 0; j < 31; ++j) w[j] = *(const f32x2*)(w_dw + j * 1024 + c);
    const f32x2 bias = *(const f32x2*)(b_dw + c);
    f32x2 acc[NTOK];
#pragma unroll
    for (int tt = 0; tt < NTOK; ++tt) acc[tt] = bias;
#pragma unroll
    for (int i = 0; i < NTOK + 30; ++i) { if ((i & 7) == 0) asm volatile("" ::: "memory");
        const f32x2 u = ld(i, c);
#pragma unroll
        for (int tt = 0; tt < NTOK; ++tt) { const int j = i - tt; if (j >= 0 && j <= 30) acc[tt] += u * w[j]; } }
#pragma unroll
    for (int tt = 0; tt < NTOK; ++tt) { const float s1 = wave_sum(acc[tt].x + acc[tt].y), s2 = wave_sum(acc[tt].x * acc[tt].x + acc[tt].y * acc[tt].y);
        if (lane == 0) { red[(wave * NTOK + tt) * 2] = s1; red[(wave * NTOK + tt) * 2 + 1] = s2; } }
    __syncthreads();
    const f32x2 gg = *(const f32x2*)(lg + c), bb = *(const f32x2*)(lb + c);
#pragma unroll
    for (int tt = 0; tt < NTOK; ++tt) { float s1 = 0.f, s2 = 0.f;
#pragma unroll
        for (int ww = 0; ww < 8; ++ww) { s1 += red[(ww * NTOK + tt) * 2]; s2 += red[(ww * NTOK + tt) * 2 + 1]; }
        const float mean = s1 * (1.f / 1024.f), var = s2 * (1.f / 1024.f) - mean * mean, rstd = 1.f / sqrtf(fmaxf(var, 0.f) + LN_EPS);
        f32x2 y = (acc[tt] - mean) * rstd * gg + bb;
        y.x = y.x * sigmoidf_(y.x); y.y = y.y * sigmoidf_(y.y);
        *(unsigned*)(mix0 + (size_t)tt * DM + c) = cvt_pk_bf16(y.x, y.y); }
    __syncthreads();
}
struct LdPrompt { const float* U; int b, t0;
    __device__ __forceinline__ f32x2 operator()(int i, int c) const { const int pos = t0 - 30 + i; if (pos < 0) return (f32x2){0.f, 0.f}; return *(const f32x2*)(U + (size_t)(b * 2048 + pos) * 1024 + c); } };
struct LdSample { const float* state; const float* PS; float* convs; int n;
    __device__ __forceinline__ f32x2 operator()(int i, int c) const {
        if (i < 30) return *(const f32x2*)(state + (size_t)(n * 30 + i) * 1024 + c);
        const float* pr = PS + (size_t)(n * 8 + i - 30) * DIN + 3072 + (c >> 7) * 256 + (c & 127);
        const f32x2 a = *(const f32x2*)pr, g = *(const f32x2*)(pr + 128);
        const f32x2 u = (f32x2){a.x * sigmoidf_(g.x), a.y * sigmoidf_(g.y)};
        *(f32x2*)(convs + (size_t)(n * 30 + i - 8) * 1024 + c) = u;
        return u; } };

__device__ __forceinline__ void attn_item(LAS unsigned char* lds, const bf16* QB, const bf16* KB, const bf16* VB, bf16* OP, float* LSE, int it, int tid, int lane, int wave) {
    const int bh = it / 48, rem = it - bh * 48, p = rem >> 4, idx = rem & 15;
    const int b = bh >> 3, h = bh & 7, dil = 1 << (2 * p);
    const int cls = p == 0 ? 0 : (p == 1 ? (idx & 3) : idx), blk = p == 0 ? idx : (p == 1 ? (idx >> 2) : 0);
    const int kb0 = blk == 0 ? 8 : 0;
    const int fr = lane & 15, fq = lane >> 4;
    for (int c = tid; c < 4096; c += 512) { const int row = c >> 4, ch = c & 15;
        if (row >= kb0 * 16) { const size_t tok = (size_t)(b * 2048 + (blk * 128 - 128 + row) * dil + cls);
            const v4u kv = *(const v4u*)(KB + tok * 1024 + h * 128 + ch * 8), vv = *(const v4u*)(VB + tok * 1024 + h * 128 + ch * 8);
            *(LAS v4u*)(lds + ATT_KOFF + row * ATT_KSTR + ch * 16) = kv; *(LAS v4u*)(lds + ATT_VOFF + row * ATT_VSTR + ch * 16) = vv; } }
    const int qi = wave * 16 + fr;
    const size_t tq = (size_t)(b * 2048 + (blk * 128 + qi) * dil + cls);
    bf16x8 qf[4];
#pragma unroll
    for (int ks = 0; ks < 4; ++ks) qf[ks] = *(const bf16x8*)(QB + tq * 1024 + h * 128 + ks * 32 + fq * 8);
    __syncthreads();
    f32x4 S[9];
#pragma unroll
    for (int kk = 0; kk < 9; ++kk) { const int kb = wave + kk; f32x4 a = (f32x4){0.f, 0.f, 0.f, 0.f};
#pragma unroll
        for (int ks = 0; ks < 4; ++ks) { const bf16x8 kf = *(const LAS bf16x8*)(lds + ATT_KOFF + (kb * 16 + fr) * ATT_KSTR + (ks * 32 + fq * 8) * 2);
            a = __builtin_amdgcn_mfma_f32_16x16x32_bf16(kf, qf[ks], a, 0, 0, 0); }
        S[kk] = a; }
    float mx = -INFINITY;
#pragma unroll
    for (int kk = 0; kk < 9; ++kk) { const int kb = wave + kk;
#pragma unroll
        for (int j = 0; j < 4; ++j) { const int kidx = kb * 16 + fq * 4 + j; const bool valid = (kidx >= qi) && (kidx <= qi + 128) && (kb >= kb0);
            const float s = valid ? S[kk][j] * SC2 : -INFINITY; S[kk][j] = s; mx = fmaxf(mx, s); } }
    mx = fmaxf(mx, __shfl_xor(mx, 16)); mx = fmaxf(mx, __shfl_xor(mx, 32));
    float l = 0.f;
#pragma unroll
    for (int kk = 0; kk < 9; ++kk)
#pragma unroll
        for (int j = 0; j < 4; ++j) { const float e = fast_exp2(S[kk][j] - mx); S[kk][j] = e; l += e; }
    l += __shfl_xor(l, 16); l += __shfl_xor(l, 32);
    bf16x8 pf[5];
#pragma unroll
    for (int s = 0; s < 5; ++s) { v4u w; w.x = cvt_pk_bf16(S[2 * s][0], S[2 * s][1]); w.y = cvt_pk_bf16(S[2 * s][2], S[2 * s][3]);
        if (s < 4) { w.z = cvt_pk_bf16(S[2 * s + 1][0], S[2 * s + 1][1]); w.w = cvt_pk_bf16(S[2 * s + 1][2], S[2 * s + 1][3]); } else { w.z = 0u; w.w = 0u; }
        pf[s] = __builtin_bit_cast(bf16x8, w); }
    const float rl = 1.0f / l;
    bf16* orow = OP + (size_t)p * ((size_t)MP * 1024) + tq * 1024 + h * 128;
#pragma unroll
    for (int db = 0; db < 8; ++db) { f32x4 o = (f32x4){0.f, 0.f, 0.f, 0.f};
#pragma unroll
        for (int s = 0; s < 5; ++s) { int kbA = wave + 2 * s, kbB = wave + 2 * s + 1; kbA = kbA < kb0 ? kb0 : kbA; kbB = kbB < kb0 ? kb0 : (kbB > 15 ? 15 : kbB);
            const s16x4 r1 = __builtin_bit_cast(s16x4, __builtin_amdgcn_ds_read_tr16_b64_v4i16((LAS s16x4*)(lds + ATT_VOFF + (kbA * 16 + fq * 4 + (fr >> 2)) * ATT_VSTR + (db * 16 + 4 * (fr & 3)) * 2)));
            const s16x4 r2 = __builtin_bit_cast(s16x4, __builtin_amdgcn_ds_read_tr16_b64_v4i16((LAS s16x4*)(lds + ATT_VOFF + (kbB * 16 + fq * 4 + (fr >> 2)) * ATT_VSTR + (db * 16 + 4 * (fr & 3)) * 2)));
            const bf16x8 vf = (bf16x8){r1[0], r1[1], r1[2], r1[3], r2[0], r2[1], r2[2], r2[3]};
            o = __builtin_amdgcn_mfma_f32_16x16x32_bf16(vf, pf[s], o, 0, 0, 0); }
        v2u w; w.x = cvt_pk_bf16(o[0] * rl, o[1] * rl); w.y = cvt_pk_bf16(o[2] * rl, o[3] * rl);
        *(v2u*)(orow + db * 16 + fq * 4) = w; }
    if (fq == 0) LSE[(size_t)p * (MP * 8) + tq * 8 + h] = mx + __builtin_amdgcn_logf(l);
    __syncthreads();
}

__device__ __forceinline__ void sattn_item(LAS float* sc, const float* PS, const float* ck, const float* cv, bf16* MIXS, float* kws, float* vws, int n, int t, int h, int lane) {
    const float* prow = PS + (size_t)(n * 8 + t) * DIN;
    const int grp = lane >> 4, sub = lane & 15;
    const f32x4 q0 = *(const f32x4*)(prow + h * 128 + sub * 8), q1 = *(const f32x4*)(prow + h * 128 + sub * 8 + 4);
#pragma unroll 4
    for (int it = 0; it < 97; ++it) { const int kk = it * 4 + grp, kc = kk > 386 ? 386 : kk; const int p = kc >= 258 ? 2 : (kc >= 129 ? 1 : 0), j = kc - 129 * p; const int e = 2048 + t - (j << (2 * p));
        const float* kr = (e < 2048) ? ck + ((size_t)(n * 2048 + e) * 8 + h) * 128 : PS + (size_t)(n * 8 + e - 2048) * DIN + 1024 + h * 128;
        const f32x4 k0 = *(const f32x4*)(kr + sub * 8), k1 = *(const f32x4*)(kr + sub * 8 + 4);
        float d = (q0.x * k0.x + q0.y * k0.y) + (q0.z * k0.z + q0.w * k0.w) + (q1.x * k1.x + q1.y * k1.y) + (q1.z * k1.z + q1.w * k1.w);
        d += __shfl_xor(d, 1); d += __shfl_xor(d, 2); d += __shfl_xor(d, 4); d += __shfl_xor(d, 8);
        if (sub == 0 && kk < 387) sc[kk] = d * SC2; }
    LDS_WAIT(); asm volatile("" ::: "memory");
    float v[7]; float m = -INFINITY;
#pragma unroll
    for (int i = 0; i < 7; ++i) { const int kk = lane + 64 * i; v[i] = kk < 387 ? sc[kk] : -INFINITY; m = fmaxf(m, v[i]); }
    m = wave_max(m); float l = 0.f;
#pragma unroll
    for (int i = 0; i < 7; ++i) { const int kk = lane + 64 * i; const float e = fast_exp2(v[i] - m); l += e; if (kk < 387) sc[kk] = e; }
    l = wave_sum(l);
    LDS_WAIT(); asm volatile("" ::: "memory");
    f32x2 o = (f32x2){0.f, 0.f}; const int d2 = lane * 2;
#pragma unroll
    for (int p = 0; p < 3; ++p) {
#pragma unroll 8
        for (int j = 0; j < 129; ++j) { const int e = 2048 + t - (j << (2 * p));
            const float* vr = (e < 2048) ? cv + ((size_t)(n * 2048 + e) * 8 + h) * 128 : PS + (size_t)(n * 8 + e - 2048) * DIN + 2048 + h * 128;
            const float pw = sc[p * 129 + j]; const f32x2 vv = *(const f32x2*)(vr + d2); o += vv * pw; } }
    const float rl = 1.0f / l;
    *(unsigned*)(MIXS + (size_t)(n * 8 + t) * DM + h * 128 + d2) = cvt_pk_bf16(o.x * rl, o.y * rl);
    const size_t orow = ((size_t)(n * 2048 + 2040 + t) * 8 + h) * 128 + d2;
    *(f32x2*)(kws + orow) = *(const f32x2*)(prow + 1024 + h * 128 + d2);
    *(f32x2*)(vws + orow) = *(const f32x2*)(prow + 2048 + h * 128 + d2);
    LDS_WAIT(); asm volatile("" ::: "memory");
}

struct Args { const float* in[17]; float* out; unsigned char* ws; int ph_lo, ph_hi; };
__global__ void __launch_bounds__(512, 2) fwd_kernel(Args args) {
    extern __shared__ __attribute__((aligned(16))) unsigned char lds_raw[];
    LAS unsigned char* lds = (LAS unsigned char*)lds_raw;
    const int tid = threadIdx.x, lane = tid & 63, wave = __builtin_amdgcn_readfirstlane(tid >> 6);
    const int G = gridDim.x, bx = blockIdx.x;
    const int vb = (G % 8 == 0) ? (bx % 8) * (G / 8) + bx / 8 : bx;
    const int gtid = vb * 512 + tid, NT = G * 512;
    const int gw = vb * 8 + wave, NGW = G * 8;
    cg::grid_group grid = cg::this_grid();
    const int lo = args.ph_lo, hi = args.ph_hi;
#ifndef PH_MASK
#define PH_MASK 0x1FF
#endif
#define IN(k) (((PH_MASK >> (k)) & 1) && lo <= (k) && (k) < hi)
#define SEAM(k) do { if (IN(k) && IN((k) + 1)) grid.sync(); } while (0)
    unsigned char* ws = args.ws; float* out = args.out;
    const float* x_prompt = args.in[0]; const float* x_sample = args.in[1]; const float* cache_k = args.in[2]; const float* cache_v = args.in[3]; const float* state_conv = args.in[4];
    const float* w_in = args.in[5]; const float* w_dw = args.in[6]; const float* b_dw = args.in[7]; const float* lncg = args.in[8]; const float* lncb = args.in[9];
    const float* w_out = args.in[10]; const float* ln1g = args.in[11]; const float* ln1b = args.in[12]; const float* w_up = args.in[13]; const float* w_down = args.in[14];
    const float* ln2g = args.in[15]; const float* ln2b = args.in[16];
    bf16* WIN = (bf16*)(ws + WS_WIN); bf16* WOUT = (bf16*)(ws + WS_WOUT); bf16* WUP = (bf16*)(ws + WS_WUP); bf16* WDN = (bf16*)(ws + WS_WDN);
    float* T1 = (float*)(ws + WS_T1); bf16* HB = (bf16*)(ws + WS_HB);
    bf16* XS = (bf16*)(ws + WS_XS); bf16* MIXS = (bf16*)(ws + WS_MIXS); bf16* HBS = (bf16*)(ws + WS_HBS); float* T1S = (float*)(ws + WS_T1S); float* PS = (float*)(ws + WS_PS); bf16* RS = (bf16*)(ws + WS_RS);
    bf16* XB = (bf16*)(ws + WS_XB); bf16* MIXED = (bf16*)(ws + WS_XB); bf16* QB = (bf16*)(ws + WS_QB); bf16* KB = (bf16*)(ws + WS_KB); bf16* VB = (bf16*)(ws + WS_VB);
    float* U = (float*)(ws + WS_U); bf16* OP = (bf16*)(ws + WS_OP); float* LSE = (float*)(ws + WS_LSE); bf16* R = (bf16*)(ws + WS_R);

    if (IN(0)) {
        LAS float* scr = (LAS float*)(lds + wave * 8448);
        constexpr int I_IN = 32 * 160, I_OUT = 32 * 64, I_UP = 32 * 256, I_DN = 128 * 64;
        for (int it = gw; it < I_IN + I_OUT + I_UP + I_DN; it += NGW) {
            int r = it;
            if (r < I_IN) { const int kb = r / 160, nb = r % 160; transpose_item(w_in, DM, DIN, WIN, win_dst(32 * nb), scr, 64 * kb, 32 * nb, lane); continue; } r -= I_IN;
            if (r < I_OUT) { const int kb = r / 64, nb = r % 64; transpose_item(w_out, DM, DM, WOUT, 32 * nb, scr, 64 * kb, 32 * nb, lane); continue; } r -= I_OUT;
            if (r < I_UP) { const int kb = r / 256, nb = r % 256; transpose_item(w_up, DM, DFF, WUP, 32 * nb, scr, 64 * kb, 32 * nb, lane); continue; } r -= I_UP;
            { const int kb = r / 64, nb = r % 64; transpose_item(w_down, DFF, DM, WDN, 32 * nb, scr, 64 * kb, 32 * nb, lane); }
        }
        for (int i = gtid; i < MP * DM / 8; i += NT) { const f32x4 a = ((const f32x4*)x_prompt)[2 * i], b = ((const f32x4*)x_prompt)[2 * i + 1];
            v4u o; o.x = cvt_pk_bf16(a.x, a.y); o.y = cvt_pk_bf16(a.z, a.w); o.z = cvt_pk_bf16(b.x, b.y); o.w = cvt_pk_bf16(b.z, b.w); ((v4u*)XB)[i] = o; }
        for (int i = gtid; i < MS * DM / 8; i += NT) { const f32x4 a = ((const f32x4*)x_sample)[2 * i], b = ((const f32x4*)x_sample)[2 * i + 1];
            v4u o; o.x = cvt_pk_bf16(a.x, a.y); o.y = cvt_pk_bf16(a.z, a.w); o.z = cvt_pk_bf16(b.x, b.y); o.w = cvt_pk_bf16(b.z, b.w); ((v4u*)XS)[i] = o; }
        {
            const f32x4* sk = (const f32x4*)cache_k; const f32x4* sv = (const f32x4*)cache_v; f32x4* dk = (f32x4*)(out + O_KS); f32x4* dv = (f32x4*)(out + O_VS);
            for (int i = gtid; i < 8 * 522240; i += NT) { const int n = i / 522240, r = i - n * 522240; const size_t d = (size_t)n * 524288 + r;
                dk[d] = sk[d + 2048]; dv[d] = sv[d + 2048]; }
            const f32x4* ss = (const f32x4*)state_conv; f32x4* dc = (f32x4*)(out + O_CS);
            for (int i = gtid; i < 8 * 5632; i += NT) { const int n = i / 5632, r = i - n * 5632; dc[(size_t)n * 7680 + r] = ss[(size_t)n * 7680 + 2048 + r]; }
        }
    }
    SEAM(0);
    if (IN(1)) {
        pg8::Gemm g{XB, WIN, MP, DIN, DM}; pg8::StaticOrder S; S.init(MP, DIN, G, bx);
        EpiG1 E{QB, U, out + O_KP, out + O_CP};
        pg8::gemm_phase<EpiG1, pg8::StaticOrder, true, true>(lds, g, S, E);
        skinny_phase(lds, XS, WIN, DIN, DM, (G == 256) ? (bx >= 128 ? bx - 128 : (1 << 30)) : vb, (G == 256) ? 128 : G, SkStore{PS, DIN});
    }
    SEAM(1);
    if (IN(2)) {
#ifndef NO_ATTN
        for (int it = bx; it < 1536; it += G) attn_item(lds, QB, KB, VB, OP, LSE, it, tid, lane, wave);
#endif
#ifndef NO_CONV
        for (int it = bx; it < 1032; it += G) {
            if (it < 1024) { const int b = it >> 8, t0 = (it & 255) * 8;
                conv_core<8>(LdPrompt{U, b, t0}, w_dw, b_dw, lncg, lncb, MIXED + (size_t)(b * 2048 + t0) * DM + 1024, (LAS float*)lds, tid, lane, wave); }
            else { const int n = it - 1024;
                conv_core<8>(LdSample{state_conv, PS, out + O_CS, n}, w_dw, b_dw, lncg, lncb, MIXS + (size_t)(n * 8) * DM + 1024, (LAS float*)lds, tid, lane, wave); }
        }
#endif
#ifndef NO_SATTN
        for (int it = G - 1 - bx; it < 64; it += G) sattn_item((LAS float*)(lds + 4096 + wave * 1600), PS, cache_k, cache_v, MIXS, out + O_KS, out + O_VS, it >> 3, it & 7, wave, lane);
#endif
    }
    SEAM(2);
    if (IN(3)) {
        for (int i = gtid; i < MP * 128; i += NT) { const int tok = i >> 7, h = (i >> 4) & 7, ch = i & 15;
            const float l0 = LSE[(size_t)tok * 8 + h], l1 = LSE[(size_t)MP * 8 + (size_t)tok * 8 + h], l2 = LSE[(size_t)2 * MP * 8 + (size_t)tok * 8 + h];
            const float m = fmaxf(l0, fmaxf(l1, l2)); float w0 = fast_exp2(l0 - m), w1 = fast_exp2(l1 - m), w2 = fast_exp2(l2 - m); const float inv = 1.0f / (w0 + w1 + w2); w0 *= inv; w1 *= inv; w2 *= inv;
            const size_t off = (size_t)tok * 1024 + h * 128 + ch * 8;
            const v4u a0 = *(const v4u*)(OP + off), a1 = *(const v4u*)(OP + (size_t)MP * 1024 + off), a2 = *(const v4u*)(OP + (size_t)2 * MP * 1024 + off);
            v4u o;
#pragma unroll
            for (int e = 0; e < 4; ++e) { const float lo_ = w0 * __uint_as_float(a0[e] << 16) + w1 * __uint_as_float(a1[e] << 16) + w2 * __uint_as_float(a2[e] << 16);
                const float hi_ = w0 * __uint_as_float(a0[e] & 0xffff0000u) + w1 * __uint_as_float(a1[e] & 0xffff0000u) + w2 * __uint_as_float(a2[e] & 0xffff0000u);
                o[e] = cvt_pk_bf16(lo_, hi_); }
            *(v4u*)(MIXED + (size_t)tok * DM + h * 128 + ch * 8) = o; }
    }
    SEAM(3);
    if (IN(4)) {
        pg8::Gemm g{MIXED, WOUT, MP, DM, DM}; pg8::StaticOrder S; S.init(MP, DM, G, bx);
        EpiRes E{x_prompt, T1};
        pg8::gemm_phase<EpiRes, pg8::StaticOrder, true, true>(lds, g, S, E);
        skinny_phase(lds, MIXS, WOUT, DM, DM, vb, G, SkRes{x_sample, T1S});
    }
    SEAM(4);
    if (IN(5)) {
        for (int r = gw; r < MP + MS; r += NGW) {
            if (r < MP) ln_row<true>(T1 + (size_t)r * DM, T1 + (size_t)r * DM, HB + (size_t)r * DM, ln1g, ln1b, lane);
            else { const int rs = r - MP; ln_row<true>(T1S + (size_t)rs * DM, T1S + (size_t)rs * DM, HBS + (size_t)rs * DM, ln1g, ln1b, lane); }
        }
    }
    SEAM(5);
    if (IN(6)) {
        pg8::Gemm g{HB, WUP, MP, DFF, DM}; pg8::StaticOrder S; S.init(MP, DFF, G, bx);
        EpiRelu2 E{R};
        pg8::gemm_phase<EpiRelu2, pg8::StaticOrder, true, true>(lds, g, S, E);
        skinny_phase(lds, HBS, WUP, DFF, DM, vb, G, SkRelu2{RS});
    }
    SEAM(6);
    if (IN(7)) {
        pg8::Gemm g{R, WDN, MP, DM, DFF}; pg8::StaticOrder S; S.init(MP, DM, G, bx);
        EpiRes E{T1, out + O_YP};
        pg8::gemm_phase<EpiRes, pg8::StaticOrder, true, true>(lds, g, S, E);
        skinny_phase(lds, RS, WDN, DM, DFF, vb, G, SkRes{T1S, out + O_YS});
    }
    SEAM(7);
    if (IN(8)) {
        for (int r = gw; r < MP + MS; r += NGW) { float* yr = out + (size_t)r * DM;
            ln_row<false>(yr, yr, nullptr, ln2g, ln2b, lane); }
    }
#undef IN
#undef SEAM
}

extern "C" void kernel_launch(void* const* d_in, const int* in_sizes, int n_in, void* d_out, int out_size, void* d_ws, size_t ws_size, hipStream_t stream) {
    static int grid = 0;
    if (grid == 0) {
        if (n_in != 17 || (size_t)out_size != O_END || ws_size < WS_END) { fprintf(stderr, "kernel_launch: unexpected shapes (n_in %d out %d ws %zu)\n", n_in, out_size, ws_size); grid = -1; return; }
        int dev = 0, cus = 0, per_cu = 0;
        hipGetDevice(&dev); hipDeviceGetAttribute(&cus, hipDeviceAttributeMultiprocessorCount, dev);
        if (hipFuncSetAttribute((const void*)fwd_kernel, hipFuncAttributeMaxDynamicSharedMemorySize, LDS_BYTES) != hipSuccess) { fprintf(stderr, "kernel_launch: hipFuncSetAttribute failed\n"); grid = -1; return; }
        if (hipOccupancyMaxActiveBlocksPerMultiprocessor(&per_cu, (const void*)fwd_kernel, 512, LDS_BYTES) != hipSuccess || per_cu < 1) { fprintf(stderr, "kernel_launch: occupancy query gave %d\n", per_cu); per_cu = 1; }
        (void)hipGetLastError();
        grid = cus * 1;
    }
    if (grid < 0) return;
    Args a{};
    for (int i = 0; i < 17; ++i) a.in[i] = (const float*)d_in[i];
    a.out = (float*)d_out; a.ws = (unsigned char*)d_ws;
    if (MK_N_LAUNCHES == 1) {
        a.ph_lo = 0; a.ph_hi = N_PHASES;
        void* kargs[] = {&a};
        hipError_t e = hipLaunchCooperativeKernel((const void*)fwd_kernel, dim3(grid), dim3(512), kargs, LDS_BYTES, stream);
        if (e != hipSuccess) fprintf(stderr, "cooperative launch failed: %s (grid %d)\n", hipGetErrorString(e), grid);
    } else {
        for (int ph = 0; ph < N_PHASES; ++ph) { a.ph_lo = ph; a.ph_hi = ph + 1;
            hipLaunchKernelGGL(fwd_kernel, dim3(grid), dim3(512), LDS_BYTES, stream, a); }
    }
}
```

```cpp
#include <hip/hip_runtime.h>
#include <hip/hip_cooperative_groups.h>
#include <cstdio>
#include <cstdint>
namespace cg = cooperative_groups;
namespace pg8 {
#define PG8_LAS __attribute__((address_space(3)))
typedef unsigned short bf16_t;
typedef short bf16x8 __attribute__((ext_vector_type(8)));
typedef float f32x4 __attribute__((ext_vector_type(4)));
typedef unsigned u32x4 __attribute__((ext_vector_type(4)));
constexpr int BM = 256, BK = 64, HALF = 128, HTB = HALF * BK * 2  , STAGE_BYTES = 8 * HTB, NXCD = 8, WGM = 8;

__host__ __device__ __forceinline__ int lds_byte(int r, int c) { const int st = (r >> 4) * 2 + (c >> 5), rr = r & 15, cc = c & 31, ob = rr * 64 + cc * 2; return st * 1024 + (ob ^ (((ob >> 9) & 1) << 5)); }
__host__ __device__ __forceinline__ void stage_rc(int b, int& R, int& C) { const int st = b / 1024, sb = b % 1024, swz = sb ^ (((sb >> 9) & 1) << 5); R = (st >> 1) * 16 + swz / 64; C = (st & 1) * 32 + (swz % 64) / 2; }
__host__ __device__ __forceinline__ int perm32(int rho) { const int n = rho >> 4, i = rho & 15; return 8 * (i >> 2) + 4 * n + (i & 3); }

struct Unit { int pm, pn; };
struct Gemm { const bf16_t* A; const bf16_t* Bt; int M, N, K; };

struct StaticOrder {
    int nM, nN, nwg, G, c;
    __host__ __device__ void init(int M, int N, int G_, int c_) { nM = M / BM; nN = N / BM; nwg = nM * nN; G = G_; c = c_; }
    __host__ __device__ bool next(int i, Unit& u) const {
        const long L = (long)i * G + c; if (L >= nwg) return false;
        int wgid = (int)L; { const int q = nwg / NXCD, r = nwg % NXCD, xcd = wgid % NXCD, off = wgid / NXCD; wgid = (xcd < r ? xcd * (q + 1) : r * (q + 1) + (xcd - r) * q) + off; }
        const int nig = WGM * nN, gid = wgid / nig, fm = gid * WGM, gsz = (nM - fm) < WGM ? (nM - fm) : WGM;
        u.pm = fm + ((wgid % nig) % gsz); u.pn = (wgid % nig) / gsz; return true;
    }
    __device__ __forceinline__ void a_ready(const Unit&) const {}
    __device__ __forceinline__ void done(const Unit&) const {}
};

__device__ __forceinline__ unsigned cvt_pk_bf16(float lo, float hi) { unsigned r; asm volatile("v_cvt_pk_bf16_f32 %0, %1, %2" : "=v"(r) : "v"(lo), "v"(hi)); return r; }
template <class Epi, class Sched, bool ALIGN_EPI = false, bool SP2 = false>
__device__ __forceinline__ void gemm_phase(PG8_LAS unsigned char* lds, const Gemm g, const Sched& S, const Epi& E) {
    const int tid = threadIdx.x, wid = __builtin_amdgcn_readfirstlane(tid >> 6), lane = tid & 63, wr = wid >> 2, wc = wid & 3, fr = lane & 15, fq = lane >> 4;
    const int K = g.K, nt = K / BK;
    unsigned voffA[2], voffB[2];
#pragma unroll
    for (int i = 0; i < 2; ++i) { int R, C; stage_rc(tid * 16 + i * 8192, R, C); const int Rb = Epi::PERM ? ((R & ~31) + perm32(R & 31)) : R;
        voffA[i] = (unsigned)(R * K + C) * 2u; voffB[i] = (unsigned)(Rb * K + C) * 2u; }
    const size_t kstep = (size_t)(BK * 2);
    const size_t hstep = (size_t)HALF * K * 2;
    const size_t tstep = 2 * hstep;
    const unsigned ldsw = (unsigned)wid * 1024u;
    const int aoff = lds_byte(wr * 64 + fr, fq * 8), boff = lds_byte(wc * 32 + fr, fq * 8);
#define PG8_SA(b, h) (((b) * 2 + (h)) * HTB)
#define PG8_SB(b, h) ((4 + (b) * 2 + (h)) * HTB)
#define PG8_STAGE(bufoff, gbase, voff) do { _Pragma("unroll") for (int _i = 0; _i < 2; ++_i) \
        __builtin_amdgcn_global_load_lds((const unsigned*)((const char*)(gbase) + (voff)[_i]), (PG8_LAS unsigned*)(lds + (bufoff) + ldsw + _i * 8192), 16, 0, 0); } while (0)
#define PG8_LDA(dst, b, h) do { _Pragma("unroll") for (int m = 0; m < 4; ++m) _Pragma("unroll") for (int k = 0; k < 2; ++k) dst[m][k] = *(const PG8_LAS bf16x8*)(lds + PG8_SA(b, h) + aoff + m * 2048 + k * 1024); } while (0)
#define PG8_LDB(dst, b, h) do { _Pragma("unroll") for (int n = 0; n < 2; ++n) _Pragma("unroll") for (int k = 0; k < 2; ++k) dst[n][k] = *(const PG8_LAS bf16x8*)(lds + PG8_SB(b, h) + boff + n * 2048 + k * 1024); } while (0)
#define PG8_MMA(ai, bj, At, Bt) do { __builtin_amdgcn_s_setprio(1); _Pragma("unroll") for (int m = 0; m < 4; ++m) _Pragma("unroll") for (int n = 0; n < 2; ++n) _Pragma("unroll") for (int k = 0; k < 2; ++k) \
        acc[ai][bj][m][n] = __builtin_amdgcn_mfma_f32_16x16x32_bf16(Bt[n][k], At[m][k], acc[ai][bj][m][n], 0, 0, 0); __builtin_amdgcn_s_setprio(0); } while (0)
#define PG8_WAIT_V(n) asm volatile("s_waitcnt vmcnt(" #n ")" ::: "memory")
#define PG8_WAIT_L(n) asm volatile("s_waitcnt lgkmcnt(" #n ")" ::: "memory")
#define PG8_BAR __builtin_amdgcn_s_barrier()
#define PG8_SCHED __builtin_amdgcn_sched_barrier(0)
    Unit cur, nxt; int ui = 0;
    if (!S.next(0, cur)) return;
    f32x4 acc[2][2][4][2];
#pragma unroll
    for (int a = 0; a < 2; ++a)
#pragma unroll
        for (int b = 0; b < 2; ++b)
#pragma unroll
            for (int m = 0; m < 4; ++m)
#pragma unroll
                for (int n = 0; n < 2; ++n) acc[a][b][m][n] = (f32x4){0.f, 0.f, 0.f, 0.f};
    bf16x8 At[4][2], B0[2][2], B1[2][2];
    const char* cA = (const char*)g.A + (size_t)cur.pm * tstep; const char* cB = (const char*)g.Bt + (size_t)cur.pn * tstep;
    S.a_ready(cur);
    if constexpr (SP2) {
        PG8_STAGE(PG8_SB(0, 0), cB, voffB); PG8_STAGE(PG8_SB(0, 1), cB + hstep, voffB); PG8_STAGE(PG8_SA(0, 0), cA, voffA); PG8_STAGE(PG8_SA(0, 1), cA + hstep, voffA);
        if (wr == 1) PG8_BAR;
        PG8_WAIT_V(2); PG8_BAR;
        PG8_STAGE(PG8_SB(1, 0), cB + kstep, voffB); PG8_STAGE(PG8_SA(1, 0), cA + kstep, voffA); PG8_STAGE(PG8_SB(1, 1), cB + hstep + kstep, voffB);
        PG8_WAIT_V(6); PG8_BAR;
    } else {
        PG8_STAGE(PG8_SB(0, 0), cB, voffB); PG8_STAGE(PG8_SA(0, 0), cA, voffA); PG8_STAGE(PG8_SB(0, 1), cB + hstep, voffB); PG8_STAGE(PG8_SA(0, 1), cA + hstep, voffA);
        if (wr == 1) PG8_BAR;
        PG8_WAIT_V(4); PG8_BAR;
        PG8_STAGE(PG8_SB(1, 0), cB + kstep, voffB); PG8_STAGE(PG8_SA(1, 0), cA + kstep, voffA); PG8_STAGE(PG8_SB(1, 1), cB + hstep + kstep, voffB);
        PG8_WAIT_V(6); PG8_BAR;
    }
    for (;;) {
        const bool has_next = S.next(ui + 1, nxt);
        const char* nA = has_next ? (const char*)g.A + (size_t)nxt.pm * tstep : cA; const char* nB = has_next ? (const char*)g.Bt + (size_t)nxt.pn * tstep : cB;
        for (int t = 0; t < nt; t += 2) {
            const bool last = (t == nt - 2);
            const char* a1 = cA + (size_t)(t + 1) * kstep;
            const char* a2 = last ? nA : cA + (size_t)(t + 2) * kstep; const char* b2 = last ? nB : cB + (size_t)(t + 2) * kstep;
            const char* a3 = a2 + kstep; const char* b3 = b2 + kstep;
            if (last && has_next) S.a_ready(nxt);
            if constexpr (SP2) {
            PG8_LDB(B0, 0, 0); PG8_LDB(B1, 0, 1); PG8_SCHED; PG8_LDA(At, 0, 0); PG8_STAGE(PG8_SA(1, 1), a1 + hstep, voffA);
            PG8_WAIT_V(8); PG8_WAIT_L(0); PG8_BAR; PG8_MMA(0, 0, At, B0); PG8_MMA(0, 1, At, B1); PG8_BAR; PG8_SCHED;
            PG8_LDA(At, 0, 1); PG8_STAGE(PG8_SB(0, 0), b2, voffB); PG8_STAGE(PG8_SB(0, 1), b2 + hstep, voffB); PG8_STAGE(PG8_SA(0, 0), a2, voffA);
            PG8_WAIT_V(8); PG8_WAIT_L(0); PG8_BAR; PG8_MMA(1, 0, At, B0); PG8_MMA(1, 1, At, B1); PG8_BAR; PG8_SCHED;
            PG8_LDB(B0, 1, 0); PG8_LDB(B1, 1, 1); PG8_SCHED; PG8_LDA(At, 1, 0); PG8_STAGE(PG8_SA(0, 1), a2 + hstep, voffA);
            PG8_WAIT_V(8); PG8_WAIT_L(0); PG8_BAR; PG8_MMA(0, 0, At, B0); PG8_MMA(0, 1, At, B1); PG8_BAR; PG8_SCHED;
            PG8_LDA(At, 1, 1); PG8_STAGE(PG8_SB(1, 0), b3, voffB); PG8_STAGE(PG8_SB(1, 1), b3 + hstep, voffB); PG8_STAGE(PG8_SA(1, 0), a3, voffA);
            PG8_WAIT_V(8); PG8_WAIT_L(0); PG8_BAR; PG8_MMA(1, 0, At, B0); PG8_MMA(1, 1, At, B1); PG8_BAR; PG8_SCHED;
            } else {
            PG8_LDB(B0, 0, 0); PG8_SCHED; PG8_LDA(At, 0, 0); PG8_STAGE(PG8_SA(1, 1), a1 + hstep, voffA);
            PG8_WAIT_L(8); PG8_BAR; PG8_WAIT_L(0); PG8_MMA(0, 0, At, B0); PG8_BAR; PG8_SCHED;
            PG8_LDB(B1, 0, 1); PG8_STAGE(PG8_SB(0, 0), b2, voffB);
            PG8_BAR; PG8_WAIT_L(0); PG8_MMA(0, 1, At, B1); PG8_BAR;
            PG8_LDA(At, 0, 1); PG8_STAGE(PG8_SA(0, 0), a2, voffA);
            PG8_BAR; PG8_WAIT_L(0); PG8_MMA(1, 0, At, B0); PG8_BAR; PG8_SCHED;
            PG8_STAGE(PG8_SB(0, 1), b2 + hstep, voffB);
            PG8_WAIT_V(6); PG8_BAR; PG8_MMA(1, 1, At, B1); PG8_BAR;
            PG8_LDB(B0, 1, 0); PG8_SCHED; PG8_LDA(At, 1, 0); PG8_STAGE(PG8_SA(0, 1), a2 + hstep, voffA);
            PG8_WAIT_L(8); PG8_BAR; PG8_WAIT_L(0); PG8_MMA(0, 0, At, B0); PG8_BAR; PG8_SCHED;
            PG8_LDB(B1, 1, 1); PG8_STAGE(PG8_SB(1, 0), b3, voffB);
            PG8_BAR; PG8_WAIT_L(0); PG8_MMA(0, 1, At, B1); PG8_BAR;
            PG8_LDA(At, 1, 1); PG8_STAGE(PG8_SA(1, 0), a3, voffA);
            PG8_BAR; PG8_WAIT_L(0); PG8_MMA(1, 0, At, B0); PG8_BAR; PG8_SCHED;
            PG8_STAGE(PG8_SB(1, 1), b3 + hstep, voffB);
            PG8_WAIT_V(6); PG8_BAR; PG8_MMA(1, 1, At, B1); PG8_BAR;
            }
        }
        if constexpr (ALIGN_EPI) { if (wr == 0) PG8_BAR; }
        if constexpr (!Epi::AFTER_DRAIN) { E(acc, cur, wr, wc, fr, fq); S.done(cur); }
        if (!has_next) break;
#pragma unroll
        for (int a = 0; a < 2; ++a)
#pragma unroll
            for (int b = 0; b < 2; ++b)
#pragma unroll
                for (int m = 0; m < 4; ++m)
#pragma unroll
                    for (int n = 0; n < 2; ++n) acc[a][b][m][n] = (f32x4){0.f, 0.f, 0.f, 0.f};
        cur = nxt; cA = nA; cB = nB; ++ui;
        if constexpr (ALIGN_EPI) { if (wr == 1) PG8_BAR; }
    }
    PG8_WAIT_V(0);
    if constexpr (!ALIGN_EPI) { if (wr == 0) PG8_BAR; }
    PG8_BAR;
    if constexpr (Epi::AFTER_DRAIN) { E.fused(acc, cur, wr, wc, fr, fq, lds, wid, lane); S.done(cur); }
#undef PG8_SA
#undef PG8_SB
#undef PG8_STAGE
#undef PG8_LDA
#undef PG8_LDB
#undef PG8_MMA
#undef PG8_WAIT_V
#undef PG8_WAIT_L
#undef PG8_BAR
#undef PG8_SCHED
}
}

#ifndef MK_N_LAUNCHES
#define MK_N_LAUNCHES 1
#endif
constexpr int N_PHASES = 11;
constexpr int DM = 2048, NBATCH = 4, SEQ = 2048, MP = NBATCH * SEQ, DB = 8, DS = 8, MS = DB * DS;
constexpr int NH = 8, HD = 128, DA = 1024, DC = 1024, DFF = 8192, DIN = 5120, NBUF = 2048;
constexpr float LN_EPS = 1e-5f;
constexpr float DN_ALPHA = 1.189207115002721f;
constexpr float SC2 = 0.08838834764831845f * 1.4426950408889634f;
constexpr float LOG2E = 1.4426950408889634f;

constexpr size_t O_YP = 0, O_YS = 16777216, O_KP = 16908288, O_VP = 25296896, O_CP = 33685504, O_KS = 33808384, O_VS = 50585600, O_CS = 67362816, O_END = 67608576;

constexpr size_t MiB = 1u << 20;
constexpr size_t WS_WIN = 2 * MiB, WS_WOUT = 22 * MiB, WS_WUP = 30 * MiB, WS_WDN = 62 * MiB;
constexpr size_t WS_T1 = 94 * MiB;
constexpr size_t WS_HB = 158 * MiB;
constexpr size_t WS_SMP = 190 * MiB;
constexpr size_t WS_XS = WS_SMP, WS_MIXS = WS_SMP + 256 * 1024, WS_HBS = WS_SMP + 512 * 1024, WS_T1S = WS_SMP + 1 * MiB, WS_PS = WS_SMP + 2 * MiB, WS_RS = WS_SMP + 4 * MiB;
constexpr size_t WS_XB = 196 * MiB;
constexpr size_t WS_QB = 228 * MiB, WS_KB = 244 * MiB, WS_VB = 260 * MiB;
constexpr size_t WS_U = 276 * MiB;
constexpr size_t WS_OP = 308 * MiB;
constexpr size_t WS_LSE = 356 * MiB;
constexpr size_t WS_R = 196 * MiB;
constexpr size_t WS_END = 357 * MiB;
static_assert(WS_VB - WS_KB == WS_KB - WS_QB, "q/k/v strides");

constexpr int LDS_BYTES = 147456;
constexpr int ATT_KOFF = 0, ATT_KSTR = 272, ATT_VOFF = 256 * 272, ATT_VSTR = 288;
static_assert(ATT_VOFF + 256 * ATT_VSTR <= LDS_BYTES, "attention LDS");

#define GAS __attribute__((address_space(1)))
#define LAS __attribute__((address_space(3)))
typedef unsigned short bf16;
typedef unsigned v4u __attribute__((ext_vector_type(4)));
typedef unsigned v2u __attribute__((ext_vector_type(2)));
typedef float f32x4 __attribute__((ext_vector_type(4)));
typedef float f32x2 __attribute__((ext_vector_type(2)));
typedef short bf16x8 __attribute__((ext_vector_type(8)));
typedef short s16x4 __attribute__((ext_vector_type(4)));
#define LDS_WAIT() asm volatile("s_waitcnt lgkmcnt(0)" ::: "memory")
using pg8::cvt_pk_bf16;

__device__ __forceinline__ float wave_sum(float v) {
#pragma unroll
    for (int o = 1; o < 64; o <<= 1) v += __shfl_xor(v, o);
    return v;
}
__device__ __forceinline__ float wave_max(float v) {
#pragma unroll
    for (int o = 1; o < 64; o <<= 1) v = fmaxf(v, __shfl_xor(v, o));
    return v;
}
__device__ __forceinline__ float fast_exp2(float x) { return __builtin_amdgcn_exp2f(x); }
__device__ __forceinline__ float sigmoidf_(float g) { return __builtin_amdgcn_rcpf(1.0f + fast_exp2(-g * LOG2E)); }
__device__ __forceinline__ float bf2f(unsigned short b) { return __uint_as_float(((unsigned)b) << 16); }

struct EpiG1 {
    static constexpr bool PERM = true, AFTER_DRAIN = false;
    bf16* QB; float* U; float* kout; float* convp;
    __device__ __forceinline__ void operator()(const f32x4 (&acc)[2][2][4][2], const pg8::Unit& u, int wr, int wc, int fr, int fq) const {
        const int row0 = u.pm * 256 + wr * 64 + fr;
        if (u.pn < 12) {
            const int t = u.pn >> 2; const int colt = (u.pn & 3) * 256 + wc * 32 + 8 * fq;
            bf16* B = QB + (size_t)t * ((WS_KB - WS_QB) / 2); float* O = kout + (size_t)(t == 2 ? 1 : 0) * (O_VP - O_KP);
#pragma unroll
            for (int ai = 0; ai < 2; ++ai)
#pragma unroll
                for (int m = 0; m < 4; ++m) { const size_t r = (size_t)(row0 + ai * 128 + m * 16);
#pragma unroll
                    for (int bj = 0; bj < 2; ++bj) { const f32x4 v0 = acc[ai][bj][m][0], v1 = acc[ai][bj][m][1]; const int c = colt + bj * 128;
                        v4u w; w.x = cvt_pk_bf16(v0[0], v0[1]); w.y = cvt_pk_bf16(v0[2], v0[3]); w.z = cvt_pk_bf16(v1[0], v1[1]); w.w = cvt_pk_bf16(v1[2], v1[3]);
                        *(v4u*)(B + r * 1024 + c) = w;
                        if (t != 0) { *(f32x4*)(O + r * 1024 + c) = v0; *(f32x4*)(O + r * 1024 + c + 4) = v1; } } }
        } else {
            const int j = u.pn - 12; const int colt = j * 128 + wc * 32 + 8 * fq;
#pragma unroll
            for (int ai = 0; ai < 2; ++ai)
#pragma unroll
                for (int m = 0; m < 4; ++m) { const int ri = row0 + ai * 128 + m * 16; const size_t r = (size_t)ri;
#pragma unroll
                    for (int n = 0; n < 2; ++n) { const f32x4 a = acc[ai][0][m][n], g = acc[ai][1][m][n]; f32x4 o;
#pragma unroll
                        for (int e = 0; e < 4; ++e) o[e] = a[e] * sigmoidf_(g[e]);
                        const int c = colt + 4 * n;
                        *(f32x4*)(U + r * 1024 + c) = o;
                        const int pos = ri & 2047;
                        if (pos >= 2018) *(f32x4*)(convp + ((size_t)((ri >> 11) * 30 + pos - 2018)) * 1024 + c) = o; } }
        }
    }
};
struct EpiRes {
    static constexpr bool PERM = false, AFTER_DRAIN = false;
    const float* base; float* out;
    __device__ __forceinline__ void operator()(const f32x4 (&acc)[2][2][4][2], const pg8::Unit& u, int wr, int wc, int fr, int fq) const {
        const int row0 = u.pm * 256 + wr * 64 + fr, col0 = u.pn * 256 + wc * 32 + 4 * fq;
#pragma unroll
        for (int ai = 0; ai < 2; ++ai)
#pragma unroll
            for (int m = 0; m < 4; ++m) { const size_t off = (size_t)(row0 + ai * 128 + m * 16) * DM + col0;
#pragma unroll
                for (int bj = 0; bj < 2; ++bj)
#pragma unroll
                    for (int n = 0; n < 2; ++n) { const f32x4 bs = *(const f32x4*)(base + off + bj * 128 + n * 16);
                        *(f32x4*)(out + off + bj * 128 + n * 16) = bs * DN_ALPHA + acc[ai][bj][m][n]; }
                asm volatile("" ::: "memory"); }
    }
};
struct EpiRelu2 {
    static constexpr bool PERM = true, AFTER_DRAIN = false;
    bf16* R;
    __device__ __forceinline__ void operator()(const f32x4 (&acc)[2][2][4][2], const pg8::Unit& u, int wr, int wc, int fr, int fq) const {
        const int row0 = u.pm * 256 + wr * 64 + fr, col0 = u.pn * 256 + wc * 32 + 8 * fq;
#pragma unroll
        for (int ai = 0; ai < 2; ++ai)
#pragma unroll
            for (int m = 0; m < 4; ++m) { bf16* rowp = R + (size_t)(row0 + ai * 128 + m * 16) * DFF + col0;
#pragma unroll
                for (int bj = 0; bj < 2; ++bj) { f32x4 v0 = acc[ai][bj][m][0], v1 = acc[ai][bj][m][1];
#pragma unroll
                    for (int e = 0; e < 4; ++e) { const float a = fmaxf(v0[e], 0.f), b = fmaxf(v1[e], 0.f); v0[e] = a * a; v1[e] = b * b; }
                    v4u w; w.x = cvt_pk_bf16(v0[0], v0[1]); w.y = cvt_pk_bf16(v0[2], v0[3]); w.z = cvt_pk_bf16(v1[0], v1[1]); w.w = cvt_pk_bf16(v1[2], v1[3]);
                    *(v4u*)(rowp + bj * 128) = w; } }
    }
};

template <class E>
__device__ __forceinline__ void skinny_phase(LAS unsigned char* lds, const bf16* A, const bf16* Bt, int N, int K, int first, int stride, const E& e) {
    const int tid = threadIdx.x, lane = tid & 63, wave = __builtin_amdgcn_readfirstlane(tid >> 6), fr = lane & 15, fq = lane >> 4;
    const int ksl = K >> 3, nks = ksl >> 5;
    LAS f32x4* red = (LAS f32x4*)lds;
    for (int task = first; task < (N >> 4); task += stride) {
        f32x4 acc[4];
#pragma unroll
        for (int m = 0; m < 4; ++m) acc[m] = (f32x4){0.f, 0.f, 0.f, 0.f};
        const bf16* bp = Bt + (size_t)(task * 16 + fr) * K + wave * ksl + fq * 8;
        const bf16* ap = A + (size_t)fr * K + wave * ksl + fq * 8;
#pragma unroll 4
        for (int ks = 0; ks < nks; ++ks) {
            const bf16x8 b = *(const bf16x8*)(bp + ks * 32);
#pragma unroll
            for (int m = 0; m < 4; ++m) { const bf16x8 a = *(const bf16x8*)(ap + (size_t)(m * 16) * K + ks * 32);
                acc[m] = __builtin_amdgcn_mfma_f32_16x16x32_bf16(a, b, acc[m], 0, 0, 0); }
        }
#pragma unroll
        for (int m = 0; m < 4; ++m) red[(wave * 4 + m) * 64 + lane] = acc[m];
        __syncthreads();
        {
            const int row = tid >> 3, cp = tid & 7; const int m = row >> 4, q = (row & 15) >> 2, j = row & 3;
            float v0 = 0.f, v1 = 0.f;
            const LAS float* rf = (const LAS float*)lds;
#pragma unroll
            for (int w = 0; w < 8; ++w) { v0 += rf[(((w * 4 + m) * 64) + q * 16 + 2 * cp) * 4 + j]; v1 += rf[(((w * 4 + m) * 64) + q * 16 + 2 * cp + 1) * 4 + j]; }
            e(row, task * 16 + 2 * cp, v0, v1);
        }
        __syncthreads();
    }
}
struct SkStore { float* out; int ld; __device__ __forceinline__ void operator()(int r, int c, float v0, float v1) const { *(f32x2*)(out + (size_t)r * ld + c) = (f32x2){v0, v1}; } };
struct SkRes { const float* base; float* out; __device__ __forceinline__ void operator()(int r, int c, float v0, float v1) const { const f32x2 b = *(const f32x2*)(base + (size_t)r * DM + c); *(f32x2*)(out + (size_t)r * DM + c) = (f32x2){b.x * DN_ALPHA + v0, b.y * DN_ALPHA + v1}; } };
struct SkRelu2 { bf16* R; __device__ __forceinline__ void operator()(int r, int c, float v0, float v1) const { const float a = fmaxf(v0, 0.f), b = fmaxf(v1, 0.f); *(unsigned*)(R + (size_t)r * DFF + c) = cvt_pk_bf16(a * a, b * b); } };

__device__ __forceinline__ void transpose_item(const float* W, int K, int N, bf16* WT, int dst_n0, LAS float* scr, int k0, int n0, int lane) {
#pragma unroll 8
    for (int i = 0; i < 32; ++i) { const int kk = 2 * i + (lane >> 5); scr[kk * 33 + (lane & 31)] = W[(size_t)(k0 + kk) * N + n0 + (lane & 31)]; }
    LDS_WAIT(); asm volatile("" ::: "memory");
    const int c = lane & 7;
#pragma unroll
    for (int j = 0; j < 4; ++j) { const int n = (lane >> 3) + 8 * j; const LAS float* s = scr + (8 * c) * 33 + n;
        v4u o; o.x = cvt_pk_bf16(s[0 * 33], s[1 * 33]); o.y = cvt_pk_bf16(s[2 * 33], s[3 * 33]); o.z = cvt_pk_bf16(s[4 * 33], s[5 * 33]); o.w = cvt_pk_bf16(s[6 * 33], s[7 * 33]);
        *(v4u*)(WT + (size_t)(dst_n0 + n) * K + k0 + 8 * c) = o; }
    LDS_WAIT(); asm volatile("" ::: "memory");
}
__device__ __forceinline__ int win_dst(int n0) {
    if (n0 < 3072) return n0;
    if (n0 < 4096) { const int c = n0 - 3072; return 3072 + (c >> 7) * 256 + (c & 127); }
    const int c = n0 - 4096; return 3072 + (c >> 7) * 256 + 128 + (c & 127);
}

template <bool WB>
__device__ __forceinline__ void ln_row(const float* in, float* out, bf16* outb, const float* g, const float* b, int lane) {
    const f32x4* xr = (const f32x4*)in + lane; f32x4 v[8]; float s = 0.f;
#pragma unroll
    for (int j = 0; j < 8; ++j) { v[j] = xr[64 * j]; s += (v[j].x + v[j].y) + (v[j].z + v[j].w); }
    const float mean = wave_sum(s) * (1.f / DM); float s2 = 0.f;
#pragma unroll
    for (int j = 0; j < 8; ++j) { v[j] = v[j] - mean; s2 += (v[j].x * v[j].x + v[j].y * v[j].y) + (v[j].z * v[j].z + v[j].w * v[j].w); }
    const float rstd = 1.f / sqrtf(wave_sum(s2) * (1.f / DM) + LN_EPS);
#pragma unroll
    for (int j = 0; j < 8; ++j) { const f32x4 gg = ((const f32x4*)g)[64 * j + lane], bb = ((const f32x4*)b)[64 * j + lane];
        const f32x4 o = v[j] * rstd * gg + bb; ((f32x4*)out)[64 * j + lane] = o;
        if (WB) { v2u w; w.x = cvt_pk_bf16(o.x, o.y); w.y = cvt_pk_bf16(o.z, o.w); ((v2u*)outb)[64 * j + lane] = w; } }
}

template <int NTOK, class LD>
__device__ __forceinline__ void conv_core(const LD& ld, const float* w_dw, const float* b_dw, const float* lg, const float* lb, bf16* mix0, LAS float* red, int tid, int lane, int wave) {
    const int c = tid * 2;
    f32x2 w[31];
#pragma unroll
    for (int j = 0; j < 31; ++j) w[j] = *(const f32x2*)(w_dw + j * 1024 + c);
    const f32x2 bias = *(const f32x2*)(b_dw + c);
    f32x2 acc[NTOK];
#pragma unroll
    for (int tt = 0; tt < NTOK; ++tt) acc[tt] = bias;
#pragma unroll
    for (int i = 0; i < NTOK + 30; ++i) { if ((i & 7) == 0) asm volatile("" ::: "memory");
        const f32x2 u = ld(i, c);
#pragma unroll
        for (int tt = 0; tt < NTOK; ++tt) { const int j = i - tt; if (j >= 0 && j <= 30) acc[tt] += u * w[j]; } }
#pragma unroll
    for (int tt = 0; tt < NTOK; ++tt) { const float s1 = wave_sum(acc[tt].x + acc[tt].y), s2 = wave_sum(acc[tt].x * acc[tt].x + acc[tt].y * acc[tt].y);
        if (lane == 0) { red[(wave * NTOK + tt) * 2] = s1; red[(wave * NTOK + tt) * 2 + 1] = s2; } }
    __syncthreads();
    const f32x2 gg = *(const f32x2*)(lg + c), bb = *(const f32x2*)(lb + c);
#pragma unroll
    for (int tt = 0; tt < NTOK; ++tt) { float s1 = 0.f, s2 = 0.f;
#pragma unroll
        for (int ww = 0; ww < 8; ++ww) { s1 += red[(ww * NTOK + tt) * 2]; s2 += red[(ww * NTOK + tt) * 2 + 1]; }
        const float mean = s1 * (1.f / 1024.f), var = s2 * (1.f / 1024.f) - mean * mean, rstd = 1.f / sqrtf(fmaxf(var, 0.f) + LN_EPS);
        f32x2 y = (acc[tt] - mean) * rstd * gg + bb;
        y.x = y.x * sigmoidf_(y.x); y.y = y.y * sigmoidf_(y.y);
        *(unsigned*)(mix0 + (size_t)tt * DM + c) = cvt_pk_bf16(y.x, y.y); }
    __syncthreads();
}
struct LdPrompt { const float* U; int b, t0;
    __device__ __forceinline__ f32x2 operator()(int i, int c) const { const int pos = t0 - 30 + i; if (pos < 0) return (f32x2){0.f, 0.f}; return *(const f32x2*)(U + (size_t)(b * 2048 + pos) * 1024 + c); } };
struct LdSample { const float* state; const float* PS; float* convs; int n;
    __device__ __forceinline__ f32x2 operator()(int i, int c) const {
        if (i < 30) return *(const f32x2*)(state + (size_t)(n * 30 + i) * 1024 + c);
        const float* pr = PS + (size_t)(n * 8 + i - 30) * DIN + 3072 + (c >> 7) * 256 + (c & 127);
        const f32x2 a = *(const f32x2*)pr, g = *(const f32x2*)(pr + 128);
        const f32x2 u = (f32x2){a.x * sigmoidf_(g.x), a.y * sigmoidf_(g.y)};
        *(f32x2*)(convs + (size_t)(n * 30 + i - 8) * 1024 + c) = u;
        return u; } };

__device__ __forceinline__ void attn_item(LAS unsigned char* lds, const bf16* QB, const bf16* KB, const bf16* VB, bf16* OP, float* LSE, int it, int tid, int lane, int wave) {
    const int bh = it / 48, rem = it - bh * 48, p = rem >> 4, idx = rem & 15;
    const int b = bh >> 3, h = bh & 7, dil = 1 << (2 * p);
    const int cls = p == 0 ? 0 : (p == 1 ? (idx & 3) : idx), blk = p == 0 ? idx : (p == 1 ? (idx >> 2) : 0);
    const int kb0 = blk == 0 ? 8 : 0;
    const int fr = lane & 15, fq = lane >> 4;
    for (int c = tid; c < 4096; c += 512) { const int row = c >> 4, ch = c & 15;
        if (row >= kb0 * 16) { const size_t tok = (size_t)(b * 2048 + (blk * 128 - 128 + row) * dil + cls);
            const v4u kv = *(const v4u*)(KB + tok * 1024 + h * 128 + ch * 8), vv = *(const v4u*)(VB + tok * 1024 + h * 128 + ch * 8);
            *(LAS v4u*)(lds + ATT_KOFF + row * ATT_KSTR + ch * 16) = kv; *(LAS v4u*)(lds + ATT_VOFF + row * ATT_VSTR + ch * 16) = vv; } }
    const int qi = wave * 16 + fr;
    const size_t tq = (size_t)(b * 2048 + (blk * 128 + qi) * dil + cls);
    bf16x8 qf[4];
#pragma unroll
    for (int ks = 0; ks < 4; ++ks) qf[ks] = *(const bf16x8*)(QB + tq * 1024 + h * 128 + ks * 32 + fq * 8);
    __syncthreads();
    f32x4 S[9];
#pragma unroll
    for (int kk = 0; kk < 9; ++kk) { const int kb = wave + kk; f32x4 a = (f32x4){0.f, 0.f, 0.f, 0.f};
#pragma unroll
        for (int ks = 0; ks < 4; ++ks) { const bf16x8 kf = *(const LAS bf16x8*)(lds + ATT_KOFF + (kb * 16 + fr) * ATT_KSTR + (ks * 32 + fq * 8) * 2);
            a = __builtin_amdgcn_mfma_f32_16x16x32_bf16(kf, qf[ks], a, 0, 0, 0); }
        S[kk] = a; }
    float mx = -INFINITY;
#pragma unroll
    for (int kk = 0; kk < 9; ++kk) { const int kb = wave + kk;
#pragma unroll
        for (int j = 0; j < 4; ++j) { const int kidx = kb * 16 + fq * 4 + j; const bool valid = (kidx >= qi) && (kidx <= qi + 128) && (kb >= kb0);
            const float s = valid ? S[kk][j] * SC2 : -INFINITY; S[kk][j] = s; mx = fmaxf(mx, s); } }
    mx = fmaxf(mx, __shfl_xor(mx, 16)); mx = fmaxf(mx, __shfl_xor(mx, 32));
    float l = 0.f;
#pragma unroll
    for (int kk = 0; kk < 9; ++kk)
#pragma unroll
        for (int j = 0; j < 4; ++j) { const float e = fast_exp2(S[kk][j] - mx); S[kk][j] = e; l += e; }
    l += __shfl_xor(l, 16); l += __shfl_xor(l, 32);
    bf16x8 pf[5];
#pragma unroll
    for (int s = 0; s < 5; ++s) { v4u w; w.x = cvt_pk_bf16(S[2 * s][0], S[2 * s][1]); w.y = cvt_pk_bf16(S[2 * s][2], S[2 * s][3]);
        if (s < 4) { w.z = cvt_pk_bf16(S[2 * s + 1][0], S[2 * s + 1][1]); w.w = cvt_pk_bf16(S[2 * s + 1][2], S[2 * s + 1][3]); } else { w.z = 0u; w.w = 0u; }
        pf[s] = __builtin_bit_cast(bf16x8, w); }
    const float rl = 1.0f / l;
    bf16* orow = OP + (size_t)p * ((size_t)MP * 1024) + tq * 1024 + h * 128;
#pragma unroll
    for (int db = 0; db < 8; ++db) { f32x4 o = (f32x4){0.f, 0.f, 0.f, 0.f};
#pragma unroll
        for (int s = 0; s < 5; ++s) { int kbA = wave + 2 * s, kbB = wave + 2 * s + 1; kbA = kbA < kb0 ? kb0 : kbA; kbB = kbB < kb0 ? kb0 : (kbB > 15 ? 15 : kbB);
            const s16x4 r1 = __builtin_bit_cast(s16x4, __builtin_amdgcn_ds_read_tr16_b64_v4i16((LAS s16x4*)(lds + ATT_VOFF + (kbA * 16 + fq * 4 + (fr >> 2)) * ATT_VSTR + (db * 16 + 4 * (fr & 3)) * 2)));
            const s16x4 r2 = __builtin_bit_cast(s16x4, __builtin_amdgcn_ds_read_tr16_b64_v4i16((LAS s16x4*)(lds + ATT_VOFF + (kbB * 16 + fq * 4 + (fr >> 2)) * ATT_VSTR + (db * 16 + 4 * (fr & 3)) * 2)));
            const bf16x8 vf = (bf16x8){r1[0], r1[1], r1[2], r1[3], r2[0], r2[1], r2[2], r2[3]};
            o = __builtin_amdgcn_mfma_f32_16x16x32_bf16(vf, pf[s], o, 0, 0, 0); }
        v2u w; w.x = cvt_pk_bf16(o[0] * rl, o[1] * rl); w.y = cvt_pk_bf16(o[2] * rl, o[3] * rl);
        *(v2u*)(orow + db * 16 + fq * 4) = w; }
    if (fq == 0) LSE[(size_t)p * (MP * 8) + tq * 8 + h] = mx + __builtin_amdgcn_logf(l);
    __syncthreads();
}

__device__ __forceinline__ void sattn_item(LAS float* sc, const float* PS, const float* ck, const float* cv, bf16* MIXS, float* kws, float* vws, int n, int t, int h, int lane) {
    const float* prow = PS + (size_t)(n * 8 + t) * DIN;
    const int grp = lane >> 4, sub = lane & 15;
    const f32x4 q0 = *(const f32x4*)(prow + h * 128 + sub * 8), q1 = *(const f32x4*)(prow + h * 128 + sub * 8 + 4);
#pragma unroll 4
    for (int it = 0; it < 97; ++it) { const int kk = it * 4 + grp, kc = kk > 386 ? 386 : kk; const int p = kc >= 258 ? 2 : (kc >= 129 ? 1 : 0), j = kc - 129 * p; const int e = 2048 + t - (j << (2 * p));
        const float* kr = (e < 2048) ? ck + ((size_t)(n * 2048 + e) * 8 + h) * 128 : PS + (size_t)(n * 8 + e - 2048) * DIN + 1024 + h * 128;
        const f32x4 k0 = *(const f32x4*)(kr + sub * 8), k1 = *(const f32x4*)(kr + sub * 8 + 4);
        float d = (q0.x * k0.x + q0.y * k0.y) + (q0.z * k0.z + q0.w * k0.w) + (q1.x * k1.x + q1.y * k1.y) + (q1.z * k1.z + q1.w * k1.w);
        d += __shfl_xor(d, 1); d += __shfl_xor(d, 2); d += __shfl_xor(d, 4); d += __shfl_xor(d, 8);
        if (sub == 0 && kk < 387) sc[kk] = d * SC2; }
    LDS_WAIT(); asm volatile("" ::: "memory");
    float v[7]; float m = -INFINITY;
#pragma unroll
    for (int i = 0; i < 7; ++i) { const int kk = lane + 64 * i; v[i] = kk < 387 ? sc[kk] : -INFINITY; m = fmaxf(m, v[i]); }
    m = wave_max(m); float l = 0.f;
#pragma unroll
    for (int i = 0; i < 7; ++i) { const int kk = lane + 64 * i; const float e = fast_exp2(v[i] - m); l += e; if (kk < 387) sc[kk] = e; }
    l = wave_sum(l);
    LDS_WAIT(); asm volatile("" ::: "memory");
    f32x2 o = (f32x2){0.f, 0.f}; const int d2 = lane * 2;
#pragma unroll
    for (int p = 0; p < 3; ++p) {
#pragma unroll 8
        for (int j = 0; j < 129; ++j) { const int e = 2048 + t - (j << (2 * p));
            const float* vr = (e < 2048) ? cv + ((size_t)(n * 2048 + e) * 8 + h) * 128 : PS + (size_t)(n * 8 + e - 2048) * DIN + 2048 + h * 128;
            const float pw = sc[p * 129 + j]; const f32x2 vv = *(const f32x2*)(vr + d2); o += vv * pw; } }
    const float rl = 1.0f / l;
    *(unsigned*)(MIXS + (size_t)(n * 8 + t) * DM + h * 128 + d2) = cvt_pk_bf16(o.x * rl, o.y * rl);
    const size_t orow = ((size_t)(n * 2048 + 2040 + t) * 8 + h) * 128 + d2;
    *(f32x2*)(kws + orow) = *(const f32x2*)(prow + 1024 + h * 128 + d2);
    *(f32x2*)(vws + orow) = *(const f32x2*)(prow + 2048 + h * 128 + d2);
    LDS_WAIT(); asm volatile("" ::: "memory");
}

#define XB_TMO      128
#define XB_XCNT(j)  (256  + 64 * (j))
#define XB_XSUB(j)  (1280 + 64 * (j))
#define XB_XGEN(j)  (2304 + 64 * (j))
#define XB_TOP      3328
#define XB_TOPGEN   3392
#define XCD_BAR_WORDS 3456
#define XB_SPIN_CAP (1u << 18)

__device__ __forceinline__ unsigned xb_ld(unsigned* p)              { return __hip_atomic_load(p, __ATOMIC_RELAXED, __HIP_MEMORY_SCOPE_AGENT); }
__device__ __forceinline__ unsigned xb_add(unsigned* p, unsigned v) { return __hip_atomic_fetch_add(p, v, __ATOMIC_RELAXED, __HIP_MEMORY_SCOPE_AGENT); }
__device__ __forceinline__ unsigned xb_xcc_id() { return (unsigned)__builtin_amdgcn_s_getreg((3 << 11) | 20) & 0xFu; }
#define XB_SPIN(cond, bar) do { unsigned _sp = 0; while (cond) { __builtin_amdgcn_s_sleep(1); \
    if ((++_sp & 255u) == 0u) { if (xb_ld(&(bar)[XB_TMO])) break; if (_sp > XB_SPIN_CAP) { atomicAdd(&(bar)[XB_TMO], 1u); break; } } } } while (0)

struct XcdBarrier {
    unsigned* bar; unsigned x;
    volatile LAS unsigned* st;
};

__device__ __forceinline__ XcdBarrier xcd_barrier_post(unsigned* bar, volatile LAS unsigned* st) {
    XcdBarrier b; b.bar = bar; b.x = xb_xcc_id(); b.st = st;
    if (threadIdx.x == 0) (void)xb_add(&bar[XB_XCNT(b.x)], 1u);
    return b;
}
__device__ __forceinline__ void xcd_barrier_complete(unsigned* bar, unsigned x, unsigned& nloc, unsigned& nx) {
    const unsigned G = gridDim.x * gridDim.y * gridDim.z;
    unsigned sum, cnt, mine, sp = 0u;
    for (;;) {
        sum = 0u; cnt = 0u; mine = 0u;
#pragma unroll
        for (unsigned j = 0; j < 16; ++j) { const unsigned c = xb_ld(&bar[XB_XCNT(j)]); sum += c; cnt += (c > 0u) ? 1u : 0u; mine = (j == x) ? c : mine; }
        if (sum == G) break;
        __builtin_amdgcn_s_sleep(1);
        if ((++sp & 255u) == 0u) { if (xb_ld(&bar[XB_TMO])) break; if (sp > XB_SPIN_CAP) { atomicAdd(&bar[XB_TMO], 1u); break; } }
    }
    nloc = mine > 0u ? mine : 1u; nx = cnt > 0u ? cnt : 1u;
}

__device__ __forceinline__ void xcd_barrier(const XcdBarrier& b) {
    asm volatile("s_waitcnt vmcnt(0)" ::: "memory");
    __syncthreads();
    if (threadIdx.x == 0) {
        unsigned* bar = b.bar;
        __builtin_amdgcn_s_waitcnt(0);
        unsigned nloc = b.st[0], nx = b.st[1];
        if (nloc == 0u) { xcd_barrier_complete(bar, b.x, nloc, nx); b.st[0] = nloc; b.st[1] = nx; }
        const unsigned old = xb_add(&bar[XB_XSUB(b.x)], 1u);
        const unsigned gen = old / nloc;
        if (old + 1u == (gen + 1u) * nloc) {
            __builtin_amdgcn_fence(__ATOMIC_RELEASE, "agent");
            asm volatile("s_waitcnt vmcnt(0)" ::: "memory");
            const unsigned og = xb_add(&bar[XB_TOP], 1u);
            const unsigned tg = og / nx;
            if (og + 1u == (tg + 1u) * nx) xb_add(&bar[XB_TOPGEN], 1u);
            else XB_SPIN(xb_ld(&bar[XB_TOPGEN]) == tg, bar);
            __builtin_amdgcn_fence(__ATOMIC_ACQUIRE, "agent");
            xb_add(&bar[XB_XGEN(b.x)], 1u);
            asm volatile("s_waitcnt vmcnt(0)" ::: "memory");
        } else {
            XB_SPIN(xb_ld(&bar[XB_XGEN(b.x)]) == gen, bar);
            __builtin_amdgcn_fence(__ATOMIC_ACQUIRE, "agent");
            asm volatile("s_waitcnt vmcnt(0)" ::: "memory");
        }
    }
    __syncthreads();
}

struct Args { const float* in[17]; float* out; unsigned char* ws; int ph_lo, ph_hi; };
__global__ void __launch_bounds__(512, 2) fwd_kernel(Args args) {
    extern __shared__ __attribute__((aligned(16))) unsigned char lds_raw[];
    LAS unsigned char* lds = (LAS unsigned char*)lds_raw;
    const int tid = threadIdx.x, lane = tid & 63, wave = __builtin_amdgcn_readfirstlane(tid >> 6);
    const int G = gridDim.x, bx = blockIdx.x;
    const int vb = (G % 8 == 0) ? (bx % 8) * (G / 8) + bx / 8 : bx;
    const int gtid = vb * 512 + tid, NT = G * 512;
    const int gw = vb * 8 + wave, NGW = G * 8;
    cg::grid_group grid = cg::this_grid();
    volatile LAS unsigned* MISC = (volatile LAS unsigned*)(lds + LDS_BYTES - 64);
    if (tid < 16) MISC[tid] = 0u;
    __syncthreads();
    XcdBarrier bar = xcd_barrier_post((unsigned*)(args.ws) + 4096, MISC + 8);
    if (args.ph_lo > args.ph_hi) grid.sync();
    const int lo = args.ph_lo, hi = args.ph_hi;
#ifndef REP_MASK
#define REP_MASK 0
#endif
#ifndef EXTRA_SYNCS
#define EXTRA_SYNCS 0
#endif
#define REPS(k) _Pragma("nounroll") for (int rep_ = 0; rep_ < 1 + ((REP_MASK >> (k)) & 1); ++rep_)
#ifndef PH_MASK
#define PH_MASK 0x7FF
#endif
#define IN(k) (((PH_MASK >> (k)) & 1) && lo <= (k) && (k) < hi)
#define SEAM(k) do { if (IN(k) && IN((k) + 1)) xcd_barrier(bar); } while (0)
    unsigned char* ws = args.ws; float* out = args.out;
    const float* x_prompt = args.in[0]; const float* x_sample = args.in[1]; const float* cache_k = args.in[2]; const float* cache_v = args.in[3]; const float* state_conv = args.in[4];
    const float* w_in = args.in[5]; const float* w_dw = args.in[6]; const float* b_dw = args.in[7]; const float* lncg = args.in[8]; const float* lncb = args.in[9];
    const float* w_out = args.in[10]; const float* ln1g = args.in[11]; const float* ln1b = args.in[12]; const float* w_up = args.in[13]; const float* w_down = args.in[14];
    const float* ln2g = args.in[15]; const float* ln2b = args.in[16];
    bf16* WIN = (bf16*)(ws + WS_WIN); bf16* WOUT = (bf16*)(ws + WS_WOUT); bf16* WUP = (bf16*)(ws + WS_WUP); bf16* WDN = (bf16*)(ws + WS_WDN);
    float* T1 = (float*)(ws + WS_T1); bf16* HB = (bf16*)(ws + WS_HB);
    bf16* XS = (bf16*)(ws + WS_XS); bf16* MIXS = (bf16*)(ws + WS_MIXS); bf16* HBS = (bf16*)(ws + WS_HBS); float* T1S = (float*)(ws + WS_T1S); float* PS = (float*)(ws + WS_PS); bf16* RS = (bf16*)(ws + WS_RS);
    bf16* XB = (bf16*)(ws + WS_XB); bf16* MIXED = (bf16*)(ws + WS_XB); bf16* QB = (bf16*)(ws + WS_QB); bf16* KB = (bf16*)(ws + WS_KB); bf16* VB = (bf16*)(ws + WS_VB);
    float* U = (float*)(ws + WS_U); bf16* OP = (bf16*)(ws + WS_OP); float* LSE = (float*)(ws + WS_LSE); bf16* R = (bf16*)(ws + WS_R);

    if (IN(0)) {
        LAS float* scr = (LAS float*)(lds + wave * 8448);
        constexpr int I_IN = 32 * 160, I_OUT = 32 * 64, I_UP = 32 * 256, I_DN = 128 * 64;
        for (int it = gw; it < I_IN + I_OUT + I_UP + I_DN; it += NGW) {
            int r = it;
            if (r < I_IN) { const int kb = r / 160, nb = r % 160; transpose_item(w_in, DM, DIN, WIN, win_dst(32 * nb), scr, 64 * kb, 32 * nb, lane); continue; } r -= I_IN;
            if (r < I_OUT) { const int kb = r / 64, nb = r % 64; transpose_item(w_out, DM, DM, WOUT, 32 * nb, scr, 64 * kb, 32 * nb, lane); continue; } r -= I_OUT;
            if (r < I_UP) { const int kb = r / 256, nb = r % 256; transpose_item(w_up, DM, DFF, WUP, 32 * nb, scr, 64 * kb, 32 * nb, lane); continue; } r -= I_UP;
            { const int kb = r / 64, nb = r % 64; transpose_item(w_down, DFF, DM, WDN, 32 * nb, scr, 64 * kb, 32 * nb, lane); }
        }
        for (int i = gtid; i < MP * DM / 8; i += NT) { const f32x4 a = ((const f32x4*)x_prompt)[2 * i], b = ((const f32x4*)x_prompt)[2 * i + 1];
            v4u o; o.x = cvt_pk_bf16(a.x, a.y); o.y = cvt_pk_bf16(a.z, a.w); o.z = cvt_pk_bf16(b.x, b.y); o.w = cvt_pk_bf16(b.z, b.w); ((v4u*)XB)[i] = o; }
        for (int i = gtid; i < MS * DM / 8; i += NT) { const f32x4 a = ((const f32x4*)x_sample)[2 * i], b = ((const f32x4*)x_sample)[2 * i + 1];
            v4u o; o.x = cvt_pk_bf16(a.x, a.y); o.y = cvt_pk_bf16(a.z, a.w); o.z = cvt_pk_bf16(b.x, b.y); o.w = cvt_pk_bf16(b.z, b.w); ((v4u*)XS)[i] = o; }
        {
            const f32x4* sk = (const f32x4*)cache_k; const f32x4* sv = (const f32x4*)cache_v; f32x4* dk = (f32x4*)(out + O_KS); f32x4* dv = (f32x4*)(out + O_VS);
            for (int i = gtid; i < 8 * 522240; i += NT) { const int n = i / 522240, r = i - n * 522240; const size_t d = (size_t)n * 524288 + r;
                dk[d] = sk[d + 2048]; dv[d] = sv[d + 2048]; }
            const f32x4* ss = (const f32x4*)state_conv; f32x4* dc = (f32x4*)(out + O_CS);
            for (int i = gtid; i < 8 * 5632; i += NT) { const int n = i / 5632, r = i - n * 5632; dc[(size_t)n * 7680 + r] = ss[(size_t)n * 7680 + 2048 + r]; }
        }
    }
    SEAM(0);
    for (int es_ = 0; es_ < EXTRA_SYNCS; ++es_) xcd_barrier(bar);
    if (IN(1)) {
        pg8::Gemm g{XB, WIN, MP, DIN, DM}; pg8::StaticOrder S; S.init(MP, DIN, G, bx);
        EpiG1 E{QB, U, out + O_KP, out + O_CP};
        pg8::gemm_phase<EpiG1, pg8::StaticOrder, true, true>(lds, g, S, E);
        skinny_phase(lds, XS, WIN, DIN, DM, (G == 256) ? (bx >= 128 ? bx - 128 : (1 << 30)) : vb, (G == 256) ? 128 : G, SkStore{PS, DIN});
    }
    SEAM(1);
    if (IN(2)) {
        for (int it = bx; it < 1536; it += G) attn_item(lds, QB, KB, VB, OP, LSE, it, tid, lane, wave);
    }
    if (IN(3)) {
        for (int it = bx; it < 1032; it += G) {
            if (it < 1024) { const int b = it >> 8, t0 = (it & 255) * 8;
                conv_core<8>(LdPrompt{U, b, t0}, w_dw, b_dw, lncg, lncb, MIXED + (size_t)(b * 2048 + t0) * DM + 1024, (LAS float*)lds, tid, lane, wave); }
            else { const int n = it - 1024;
                conv_core<8>(LdSample{state_conv, PS, out + O_CS, n}, w_dw, b_dw, lncg, lncb, MIXS + (size_t)(n * 8) * DM + 1024, (LAS float*)lds, tid, lane, wave); }
        }
    }
    if (IN(4)) {
        for (int it = G - 1 - bx; it < 64; it += G) sattn_item((LAS float*)(lds + 4096 + wave * 1600), PS, cache_k, cache_v, MIXS, out + O_KS, out + O_VS, it >> 3, it & 7, wave, lane);
    }
    SEAM(4);
    if (IN(5)) {
        for (int i = gtid; i < MP * 128; i += NT) { const int tok = i >> 7, h = (i >> 4) & 7, ch = i & 15;
            const float l0 = LSE[(size_t)tok * 8 + h], l1 = LSE[(size_t)MP * 8 + (size_t)tok * 8 + h], l2 = LSE[(size_t)2 * MP * 8 + (size_t)tok * 8 + h];
            const float m = fmaxf(l0, fmaxf(l1, l2)); float w0 = fast_exp2(l0 - m), w1 = fast_exp2(l1 - m), w2 = fast_exp2(l2 - m); const float inv = 1.0f / (w0 + w1 + w2); w0 *= inv; w1 *= inv; w2 *= inv;
            const size_t off = (size_t)tok * 1024 + h * 128 + ch * 8;
            const v4u a0 = *(const v4u*)(OP + off), a1 = *(const v4u*)(OP + (size_t)MP * 1024 + off), a2 = *(const v4u*)(OP + (size_t)2 * MP * 1024 + off);
            v4u o;
#pragma unroll
            for (int e = 0; e < 4; ++e) { const float lo_ = w0 * __uint_as_float(a0[e] << 16) + w1 * __uint_as_float(a1[e] << 16) + w2 * __uint_as_float(a2[e] << 16);
                const float hi_ = w0 * __uint_as_float(a0[e] & 0xffff0000u) + w1 * __uint_as_float(a1[e] & 0xffff0000u) + w2 * __uint_as_float(a2[e] & 0xffff0000u);
                o[e] = cvt_pk_bf16(lo_, hi_); }
            *(v4u*)(MIXED + (size_t)tok * DM + h * 128 + ch * 8) = o; }
    }
    SEAM(5);
    if (IN(6)) {
        pg8::Gemm g{MIXED, WOUT, MP, DM, DM}; pg8::StaticOrder S; S.init(MP, DM, G, bx);
        EpiRes E{x_prompt, T1};
        pg8::gemm_phase<EpiRes, pg8::StaticOrder, true, true>(lds, g, S, E);
        skinny_phase(lds, MIXS, WOUT, DM, DM, vb, G, SkRes{x_sample, T1S});
    }
    SEAM(6);
    if (IN(7)) {
        for (int r = gw; r < MP + MS; r += NGW) {
            if (r < MP) ln_row<true>(T1 + (size_t)r * DM, T1 + (size_t)r * DM, HB + (size_t)r * DM, ln1g, ln1b, lane);
            else { const int rs = r - MP; ln_row<true>(T1S + (size_t)rs * DM, T1S + (size_t)rs * DM, HBS + (size_t)rs * DM, ln1g, ln1b, lane); }
        }
    }
    SEAM(7);
    if (IN(8)) {
        pg8::Gemm g{HB, WUP, MP, DFF, DM}; pg8::StaticOrder S; S.init(MP, DFF, G, bx);
        EpiRelu2 E{R};
        pg8::gemm_phase<EpiRelu2, pg8::StaticOrder, true, true>(lds, g, S, E);
        skinny_phase(lds, HBS, WUP, DFF, DM, vb, G, SkRelu2{RS});
    }
    SEAM(8);
    if (IN(9)) {
        pg8::Gemm g{R, WDN, MP, DM, DFF}; pg8::StaticOrder S; S.init(MP, DM, G, bx);
        EpiRes E{T1, out + O_YP};
        pg8::gemm_phase<EpiRes, pg8::StaticOrder, true, true>(lds, g, S, E);
        skinny_phase(lds, RS, WDN, DM, DFF, vb, G, SkRes{T1S, out + O_YS});
    }
    SEAM(9);
    if (IN(10)) {
        for (int r = gw; r < MP + MS; r += NGW) { float* yr = out + (size_t)r * DM;
            ln_row<false>(yr, yr, nullptr, ln2g, ln2b, lane); }
    }
#undef IN
#undef SEAM
}

extern "C" void kernel_launch(void* const* d_in, const int* in_sizes, int n_in, void* d_out, int out_size, void* d_ws, size_t ws_size, hipStream_t stream) {
    static int grid = 0;
    if (grid == 0) {
        if (n_in != 17 || (size_t)out_size != O_END || ws_size < WS_END) { fprintf(stderr, "kernel_launch: unexpected shapes (n_in %d out %d ws %zu)\n", n_in, out_size, ws_size); grid = -1; return; }
        int dev = 0, cus = 0, per_cu = 0;
        hipGetDevice(&dev); hipDeviceGetAttribute(&cus, hipDeviceAttributeMultiprocessorCount, dev);
        if (hipFuncSetAttribute((const void*)fwd_kernel, hipFuncAttributeMaxDynamicSharedMemorySize, LDS_BYTES) != hipSuccess) { fprintf(stderr, "kernel_launch: hipFuncSetAttribute failed\n"); grid = -1; return; }
        if (hipOccupancyMaxActiveBlocksPerMultiprocessor(&per_cu, (const void*)fwd_kernel, 512, LDS_BYTES) != hipSuccess || per_cu < 1) { fprintf(stderr, "kernel_launch: occupancy query gave %d\n", per_cu); per_cu = 1; }
        (void)hipGetLastError();
        grid = cus * 1;
    }
    if (grid < 0) return;
    Args a{};
    for (int i = 0; i < 17; ++i) a.in[i] = (const float*)d_in[i];
    a.out = (float*)d_out; a.ws = (unsigned char*)d_ws;
#ifndef LAUNCH_PROG
#define LAUNCH_PROG {0, N_PHASES}
#endif
    static const int prog[] = LAUNCH_PROG;
    for (unsigned li = 0; li + 1 < sizeof(prog) / sizeof(int); li += 2) {
        a.ph_lo = prog[li]; a.ph_hi = prog[li + 1];
        (void)hipMemsetAsync(d_ws, 0, 65536, stream);
        void* kargs[] = {&a};
        hipError_t e = hipLaunchCooperativeKernel((const void*)fwd_kernel, dim3(grid), dim3(512), kargs, LDS_BYTES, stream);
        if (e != hipSuccess) fprintf(stderr, "cooperative launch failed: %s (grid %d)\n", hipGetErrorString(e), grid);
    }
}
```

```cpp
#include <hip/hip_runtime.h>
#include <hip/hip_cooperative_groups.h>
#include <cstdio>
#include <cstdint>
namespace cg = cooperative_groups;
namespace pg8 {
#define PG8_LAS __attribute__((address_space(3)))
typedef unsigned short bf16_t;
typedef short bf16x8 __attribute__((ext_vector_type(8)));
typedef float f32x4 __attribute__((ext_vector_type(4)));
typedef unsigned u32x4 __attribute__((ext_vector_type(4)));
constexpr int BM = 256, BK = 64, HALF = 128, HTB = HALF * BK * 2  , STAGE_BYTES = 8 * HTB, NXCD = 8, WGM = 8;

__host__ __device__ __forceinline__ int lds_byte(int r, int c) { const int st = (r >> 4) * 2 + (c >> 5), rr = r & 15, cc = c & 31, ob = rr * 64 + cc * 2; return st * 1024 + (ob ^ (((ob >> 9) & 1) << 5)); }
__host__ __device__ __forceinline__ void stage_rc(int b, int& R, int& C) { const int st = b / 1024, sb = b % 1024, swz = sb ^ (((sb >> 9) & 1) << 5); R = (st >> 1) * 16 + swz / 64; C = (st & 1) * 32 + (swz % 64) / 2; }
__host__ __device__ __forceinline__ int perm32(int rho) { const int n = rho >> 4, i = rho & 15; return 8 * (i >> 2) + 4 * n + (i & 3); }

struct Unit { int pm, pn; };
struct Gemm { const bf16_t* A; const bf16_t* Bt; int M, N, K; };

struct StaticOrder {
    int nM, nN, nwg, G, c;
    __host__ __device__ void init(int M, int N, int G_, int c_) { nM = M / BM; nN = N / BM; nwg = nM * nN; G = G_; c = c_; }
    __host__ __device__ bool next(int i, Unit& u) const {
        const long L = (long)i * G + c; if (L >= nwg) return false;
        int wgid = (int)L; { const int q = nwg / NXCD, r = nwg % NXCD, xcd = wgid % NXCD, off = wgid / NXCD; wgid = (xcd < r ? xcd * (q + 1) : r * (q + 1) + (xcd - r) * q) + off; }
        const int nig = WGM * nN, gid = wgid / nig, fm = gid * WGM, gsz = (nM - fm) < WGM ? (nM - fm) : WGM;
        u.pm = fm + ((wgid % nig) % gsz); u.pn = (wgid % nig) / gsz; return true;
    }
    __device__ __forceinline__ void a_ready(const Unit&) const {}
    __device__ __forceinline__ void done(const Unit&) const {}
};

__device__ __forceinline__ unsigned cvt_pk_bf16(float lo, float hi) { unsigned r; asm volatile("v_cvt_pk_bf16_f32 %0, %1, %2" : "=v"(r) : "v"(lo), "v"(hi)); return r; }
template <class Epi, class Sched, bool ALIGN_EPI = false, bool SP2 = false>
__device__ __forceinline__ void gemm_phase(PG8_LAS unsigned char* lds, const Gemm g, const Sched& S, const Epi& E) {
    const int tid = threadIdx.x, wid = __builtin_amdgcn_readfirstlane(tid >> 6), lane = tid & 63, wr = wid >> 2, wc = wid & 3, fr = lane & 15, fq = lane >> 4;
    const int K = g.K, nt = K / BK;
    unsigned voffA[2], voffB[2];
#pragma unroll
    for (int i = 0; i < 2; ++i) { int R, C; stage_rc(tid * 16 + i * 8192, R, C); const int Rb = Epi::PERM ? ((R & ~31) + perm32(R & 31)) : R;
        voffA[i] = (unsigned)(R * K + C) * 2u; voffB[i] = (unsigned)(Rb * K + C) * 2u; }
    const size_t kstep = (size_t)(BK * 2);
    const size_t hstep = (size_t)HALF * K * 2;
    const size_t tstep = 2 * hstep;
    const unsigned ldsw = (unsigned)wid * 1024u;
    const int aoff = lds_byte(wr * 64 + fr, fq * 8), boff = lds_byte(wc * 32 + fr, fq * 8);
#define PG8_SA(b, h) (((b) * 2 + (h)) * HTB)
#define PG8_SB(b, h) ((4 + (b) * 2 + (h)) * HTB)
#define PG8_STAGE(bufoff, gbase, voff) do { _Pragma("unroll") for (int _i = 0; _i < 2; ++_i) \
        __builtin_amdgcn_global_load_lds((const unsigned*)((const char*)(gbase) + (voff)[_i]), (PG8_LAS unsigned*)(lds + (bufoff) + ldsw + _i * 8192), 16, 0, 0); } while (0)
#define PG8_LDA(dst, b, h) do { _Pragma("unroll") for (int m = 0; m < 4; ++m) _Pragma("unroll") for (int k = 0; k < 2; ++k) dst[m][k] = *(const PG8_LAS bf16x8*)(lds + PG8_SA(b, h) + aoff + m * 2048 + k * 1024); } while (0)
#define PG8_LDB(dst, b, h) do { _Pragma("unroll") for (int n = 0; n < 2; ++n) _Pragma("unroll") for (int k = 0; k < 2; ++k) dst[n][k] = *(const PG8_LAS bf16x8*)(lds + PG8_SB(b, h) + boff + n * 2048 + k * 1024); } while (0)
#define PG8_MMA(ai, bj, At, Bt) do { __builtin_amdgcn_s_setprio(1); _Pragma("unroll") for (int m = 0; m < 4; ++m) _Pragma("unroll") for (int n = 0; n < 2; ++n) _Pragma("unroll") for (int k = 0; k < 2; ++k) \
        acc[ai][bj][m][n] = __builtin_amdgcn_mfma_f32_16x16x32_bf16(Bt[n][k], At[m][k], acc[ai][bj][m][n], 0, 0, 0); __builtin_amdgcn_s_setprio(0); } while (0)
#define PG8_WAIT_V(n) asm volatile("s_waitcnt vmcnt(" #n ")" ::: "memory")
#define PG8_WAIT_L(n) asm volatile("s_waitcnt lgkmcnt(" #n ")" ::: "memory")
#define PG8_BAR __builtin_amdgcn_s_barrier()
#define PG8_SCHED __builtin_amdgcn_sched_barrier(0)
    Unit cur, nxt; int ui = 0;
    if (!S.next(0, cur)) return;
    f32x4 acc[2][2][4][2];
#pragma unroll
    for (int a = 0; a < 2; ++a)
#pragma unroll
        for (int b = 0; b < 2; ++b)
#pragma unroll
            for (int m = 0; m < 4; ++m)
#pragma unroll
                for (int n = 0; n < 2; ++n) acc[a][b][m][n] = (f32x4){0.f, 0.f, 0.f, 0.f};
    bf16x8 At[4][2], B0[2][2], B1[2][2];
    const char* cA = (const char*)g.A + (size_t)cur.pm * tstep; const char* cB = (const char*)g.Bt + (size_t)cur.pn * tstep;
    S.a_ready(cur);
    if constexpr (SP2) {
        PG8_STAGE(PG8_SB(0, 0), cB, voffB); PG8_STAGE(PG8_SB(0, 1), cB + hstep, voffB); PG8_STAGE(PG8_SA(0, 0), cA, voffA); PG8_STAGE(PG8_SA(0, 1), cA + hstep, voffA);
        if (wr == 1) PG8_BAR;
        PG8_WAIT_V(2); PG8_BAR;
        PG8_STAGE(PG8_SB(1, 0), cB + kstep, voffB); PG8_STAGE(PG8_SA(1, 0), cA + kstep, voffA); PG8_STAGE(PG8_SB(1, 1), cB + hstep + kstep, voffB);
        PG8_WAIT_V(6); PG8_BAR;
    } else {
        PG8_STAGE(PG8_SB(0, 0), cB, voffB); PG8_STAGE(PG8_SA(0, 0), cA, voffA); PG8_STAGE(PG8_SB(0, 1), cB + hstep, voffB); PG8_STAGE(PG8_SA(0, 1), cA + hstep, voffA);
        if (wr == 1) PG8_BAR;
        PG8_WAIT_V(4); PG8_BAR;
        PG8_STAGE(PG8_SB(1, 0), cB + kstep, voffB); PG8_STAGE(PG8_SA(1, 0), cA + kstep, voffA); PG8_STAGE(PG8_SB(1, 1), cB + hstep + kstep, voffB);
        PG8_WAIT_V(6); PG8_BAR;
    }
    for (;;) {
        const bool has_next = S.next(ui + 1, nxt);
        const char* nA = has_next ? (const char*)g.A + (size_t)nxt.pm * tstep : cA; const char* nB = has_next ? (const char*)g.Bt + (size_t)nxt.pn * tstep : cB;
        for (int t = 0; t < nt; t += 2) {
            const bool last = (t == nt - 2);
            const char* a1 = cA + (size_t)(t + 1) * kstep;
            const char* a2 = last ? nA : cA + (size_t)(t + 2) * kstep; const char* b2 = last ? nB : cB + (size_t)(t + 2) * kstep;
            const char* a3 = a2 + kstep; const char* b3 = b2 + kstep;
            if (last && has_next) S.a_ready(nxt);
            if constexpr (SP2) {
            PG8_LDB(B0, 0, 0); PG8_LDB(B1, 0, 1); PG8_SCHED; PG8_LDA(At, 0, 0); PG8_STAGE(PG8_SA(1, 1), a1 + hstep, voffA);
            PG8_WAIT_V(8); PG8_WAIT_L(0); PG8_BAR; PG8_MMA(0, 0, At, B0); PG8_MMA(0, 1, At, B1); PG8_BAR; PG8_SCHED;
            PG8_LDA(At, 0, 1); PG8_STAGE(PG8_SB(0, 0), b2, voffB); PG8_STAGE(PG8_SB(0, 1), b2 + hstep, voffB); PG8_STAGE(PG8_SA(0, 0), a2, voffA);
            PG8_WAIT_V(8); PG8_WAIT_L(0); PG8_BAR; PG8_MMA(1, 0, At, B0); PG8_MMA(1, 1, At, B1); PG8_BAR; PG8_SCHED;
            PG8_LDB(B0, 1, 0); PG8_LDB(B1, 1, 1); PG8_SCHED; PG8_LDA(At, 1, 0); PG8_STAGE(PG8_SA(0, 1), a2 + hstep, voffA);
            PG8_WAIT_V(8); PG8_WAIT_L(0); PG8_BAR; PG8_MMA(0, 0, At, B0); PG8_MMA(0, 1, At, B1); PG8_BAR; PG8_SCHED;
            PG8_LDA(At, 1, 1); PG8_STAGE(PG8_SB(1, 0), b3, voffB); PG8_STAGE(PG8_SB(1, 1), b3 + hstep, voffB); PG8_STAGE(PG8_SA(1, 0), a3, voffA);
            PG8_WAIT_V(8); PG8_WAIT_L(0); PG8_BAR; PG8_MMA(1, 0, At, B0); PG8_MMA(1, 1, At, B1); PG8_BAR; PG8_SCHED;
            } else {
            PG8_LDB(B0, 0, 0); PG8_SCHED; PG8_LDA(At, 0, 0); PG8_STAGE(PG8_SA(1, 1), a1 + hstep, voffA);
            PG8_WAIT_L(8); PG8_BAR; PG8_WAIT_L(0); PG8_MMA(0, 0, At, B0); PG8_BAR; PG8_SCHED;
            PG8_LDB(B1, 0, 1); PG8_STAGE(PG8_SB(0, 0), b2, voffB);
            PG8_BAR; PG8_WAIT_L(0); PG8_MMA(0, 1, At, B1); PG8_BAR;
            PG8_LDA(At, 0, 1); PG8_STAGE(PG8_SA(0, 0), a2, voffA);
            PG8_BAR; PG8_WAIT_L(0); PG8_MMA(1, 0, At, B0); PG8_BAR; PG8_SCHED;
            PG8_STAGE(PG8_SB(0, 1), b2 + hstep, voffB);
            PG8_WAIT_V(6); PG8_BAR; PG8_MMA(1, 1, At, B1); PG8_BAR;
            PG8_LDB(B0, 1, 0); PG8_SCHED; PG8_LDA(At, 1, 0); PG8_STAGE(PG8_SA(0, 1), a2 + hstep, voffA);
            PG8_WAIT_L(8); PG8_BAR; PG8_WAIT_L(0); PG8_MMA(0, 0, At, B0); PG8_BAR; PG8_SCHED;
            PG8_LDB(B1, 1, 1); PG8_STAGE(PG8_SB(1, 0), b3, voffB);
            PG8_BAR; PG8_WAIT_L(0); PG8_MMA(0, 1, At, B1); PG8_BAR;
            PG8_LDA(At, 1, 1); PG8_STAGE(PG8_SA(1, 0), a3, voffA);
            PG8_BAR; PG8_WAIT_L(0); PG8_MMA(1, 0, At, B0); PG8_BAR; PG8_SCHED;
            PG8_STAGE(PG8_SB(1, 1), b3 + hstep, voffB);
            PG8_WAIT_V(6); PG8_BAR; PG8_MMA(1, 1, At, B1); PG8_BAR;
            }
        }
        if constexpr (ALIGN_EPI) { if (wr == 0) PG8_BAR; }
        if constexpr (!Epi::AFTER_DRAIN) { E(acc, cur, wr, wc, fr, fq); S.done(cur); }
        if (!has_next) break;
#pragma unroll
        for (int a = 0; a < 2; ++a)
#pragma unroll
            for (int b = 0; b < 2; ++b)
#pragma unroll
                for (int m = 0; m < 4; ++m)
#pragma unroll
                    for (int n = 0; n < 2; ++n) acc[a][b][m][n] = (f32x4){0.f, 0.f, 0.f, 0.f};
        cur = nxt; cA = nA; cB = nB; ++ui;
        if constexpr (ALIGN_EPI) { if (wr == 1) PG8_BAR; }
    }
    PG8_WAIT_V(0);
    if constexpr (!ALIGN_EPI) { if (wr == 0) PG8_BAR; }
    PG8_BAR;
    if constexpr (Epi::AFTER_DRAIN) { E.fused(acc, cur, wr, wc, fr, fq, lds, wid, lane); S.done(cur); }
#undef PG8_SA
#undef PG8_SB
#undef PG8_STAGE
#undef PG8_LDA
#undef PG8_LDB
#undef PG8_MMA
#undef PG8_WAIT_V
#undef PG8_WAIT_L
#undef PG8_BAR
#undef PG8_SCHED
}
}

#ifndef MK_N_LAUNCHES
#define MK_N_LAUNCHES 1
#endif
constexpr int N_PHASES = 11;
constexpr int DM = 2048, NBATCH = 4, SEQ = 2048, MP = NBATCH * SEQ, DB = 8, DS = 8, MS = DB * DS;
constexpr int NH = 8, HD = 128, DA = 1024, DC = 1024, DFF = 8192, DIN = 5120, NBUF = 2048;
constexpr float LN_EPS = 1e-5f;
constexpr float DN_ALPHA = 1.189207115002721f;
constexpr float SC2 = 0.08838834764831845f * 1.4426950408889634f;
constexpr float LOG2E = 1.4426950408889634f;

constexpr size_t O_YP = 0, O_YS = 16777216, O_KP = 16908288, O_VP = 25296896, O_CP = 33685504, O_KS = 33808384, O_VS = 50585600, O_CS = 67362816, O_END = 67608576;

constexpr size_t MiB = 1u << 20;
constexpr size_t WS_WIN = 2 * MiB, WS_WOUT = 22 * MiB, WS_WUP = 30 * MiB, WS_WDN = 62 * MiB;
constexpr size_t WS_T1 = 94 * MiB;
constexpr size_t WS_HB = 158 * MiB;
constexpr size_t WS_SMP = 190 * MiB;
constexpr size_t WS_XS = WS_SMP, WS_MIXS = WS_SMP + 256 * 1024, WS_HBS = WS_SMP + 512 * 1024, WS_T1S = WS_SMP + 1 * MiB, WS_PS = WS_SMP + 2 * MiB, WS_RS = WS_SMP + 4 * MiB;
constexpr size_t WS_XB = 196 * MiB;
constexpr size_t WS_QB = 228 * MiB, WS_KB = 244 * MiB, WS_VB = 260 * MiB;
constexpr size_t WS_U = 276 * MiB;
constexpr size_t WS_OP = 308 * MiB;
constexpr size_t WS_LSE = 356 * MiB;
constexpr size_t WS_R = 196 * MiB;
constexpr size_t WS_END = 357 * MiB;
static_assert(WS_VB - WS_KB == WS_KB - WS_QB, "q/k/v strides");

constexpr int LDS_BYTES = 147456;
constexpr int ATT_KOFF = 0, ATT_KSTR = 272, ATT_VOFF = 256 * 272, ATT_VSTR = 288;
static_assert(ATT_VOFF + 256 * ATT_VSTR <= LDS_BYTES, "attention LDS");

#define GAS __attribute__((address_space(1)))
#define LAS __attribute__((address_space(3)))
typedef unsigned short bf16;
typedef unsigned v4u __attribute__((ext_vector_type(4)));
typedef unsigned v2u __attribute__((ext_vector_type(2)));
typedef float f32x4 __attribute__((ext_vector_type(4)));
typedef float f32x2 __attribute__((ext_vector_type(2)));
typedef short bf16x8 __attribute__((ext_vector_type(8)));
typedef short s16x4 __attribute__((ext_vector_type(4)));
#define LDS_WAIT() asm volatile("s_waitcnt lgkmcnt(0)" ::: "memory")
using pg8::cvt_pk_bf16;

template <int CTRL> __device__ __forceinline__ float dpp_add(float v) { return v + __int_as_float(__builtin_amdgcn_update_dpp(0, __float_as_int(v), CTRL, 0xF, 0xF, true)); }
__device__ __forceinline__ float sum8(float v) { v = dpp_add<0xB1>(v); v = dpp_add<0x4E>(v); v = dpp_add<0x141>(v); return v; }
__device__ __forceinline__ float row16_sum(float v) { return dpp_add<0x140>(sum8(v)); }
__device__ __forceinline__ float rdlane(float v, int l) { return __int_as_float(__builtin_amdgcn_readlane(__float_as_int(v), l)); }
__device__ __forceinline__ float wave_sum(float v) { v = row16_sum(v); return (rdlane(v, 0) + rdlane(v, 16)) + (rdlane(v, 32) + rdlane(v, 48)); }
__device__ __forceinline__ float wave_max(float v) {
#pragma unroll
    for (int o = 1; o < 64; o <<= 1) v = fmaxf(v, __shfl_xor(v, o));
    return v;
}
__device__ __forceinline__ float fast_exp2(float x) { return __builtin_amdgcn_exp2f(x); }
__device__ __forceinline__ float sigmoidf_(float g) { return __builtin_amdgcn_rcpf(1.0f + fast_exp2(-g * LOG2E)); }
__device__ __forceinline__ float bf2f(unsigned short b) { return __uint_as_float(((unsigned)b) << 16); }

struct EpiG1 {
    static constexpr bool PERM = true, AFTER_DRAIN = false;
    bf16* QB; float* U; float* kout; float* convp;
    __device__ __forceinline__ void operator()(const f32x4 (&acc)[2][2][4][2], const pg8::Unit& u, int wr, int wc, int fr, int fq) const {
        const int row0 = u.pm * 256 + wr * 64 + fr;
        if (u.pn < 12) {
            const int t = u.pn >> 2; const int colt = (u.pn & 3) * 256 + wc * 32 + 8 * fq;
            bf16* B = QB + (size_t)t * ((WS_KB - WS_QB) / 2); float* O = kout + (size_t)(t == 2 ? 1 : 0) * (O_VP - O_KP);
#pragma unroll
            for (int ai = 0; ai < 2; ++ai)
#pragma unroll
                for (int m = 0; m < 4; ++m) { const size_t r = (size_t)(row0 + ai * 128 + m * 16);
#pragma unroll
                    for (int bj = 0; bj < 2; ++bj) { const f32x4 v0 = acc[ai][bj][m][0], v1 = acc[ai][bj][m][1]; const int c = colt + bj * 128;
                        v4u w; w.x = cvt_pk_bf16(v0[0], v0[1]); w.y = cvt_pk_bf16(v0[2], v0[3]); w.z = cvt_pk_bf16(v1[0], v1[1]); w.w = cvt_pk_bf16(v1[2], v1[3]);
                        *(v4u*)(B + r * 1024 + c) = w;
                        if (t != 0) { *(f32x4*)(O + r * 1024 + c) = v0; *(f32x4*)(O + r * 1024 + c + 4) = v1; } } }
        } else {
            const int j = u.pn - 12; const int colt = j * 128 + wc * 32 + 8 * fq;
#pragma unroll
            for (int ai = 0; ai < 2; ++ai)
#pragma unroll
                for (int m = 0; m < 4; ++m) { const int ri = row0 + ai * 128 + m * 16; const size_t r = (size_t)ri;
#pragma unroll
                    for (int n = 0; n < 2; ++n) { const f32x4 a = acc[ai][0][m][n], g = acc[ai][1][m][n]; f32x4 o;
#pragma unroll
                        for (int e = 0; e < 4; ++e) o[e] = a[e] * sigmoidf_(g[e]);
                        const int c = colt + 4 * n;
                        *(f32x4*)(U + r * 1024 + c) = o;
                        const int pos = ri & 2047;
                        if (pos >= 2018) *(f32x4*)(convp + ((size_t)((ri >> 11) * 30 + pos - 2018)) * 1024 + c) = o; } }
        }
    }
};
struct EpiRes {
    static constexpr bool PERM = false, AFTER_DRAIN = false;
    const float* base; float* out;
    __device__ __forceinline__ void operator()(const f32x4 (&acc)[2][2][4][2], const pg8::Unit& u, int wr, int wc, int fr, int fq) const {
        const int row0 = u.pm * 256 + wr * 64 + fr, col0 = u.pn * 256 + wc * 32 + 4 * fq;
#pragma unroll
        for (int ai = 0; ai < 2; ++ai)
#pragma unroll
            for (int m = 0; m < 4; ++m) { const size_t off = (size_t)(row0 + ai * 128 + m * 16) * DM + col0;
#pragma unroll
                for (int bj = 0; bj < 2; ++bj)
#pragma unroll
                    for (int n = 0; n < 2; ++n) { const f32x4 bs = *(const f32x4*)(base + off + bj * 128 + n * 16);
                        *(f32x4*)(out + off + bj * 128 + n * 16) = bs * DN_ALPHA + acc[ai][bj][m][n]; }
                asm volatile("" ::: "memory"); }
    }
};
struct EpiRelu2 {
    static constexpr bool PERM = true, AFTER_DRAIN = false;
    bf16* R;
    __device__ __forceinline__ void operator()(const f32x4 (&acc)[2][2][4][2], const pg8::Unit& u, int wr, int wc, int fr, int fq) const {
        const int row0 = u.pm * 256 + wr * 64 + fr, col0 = u.pn * 256 + wc * 32 + 8 * fq;
#pragma unroll
        for (int ai = 0; ai < 2; ++ai)
#pragma unroll
            for (int m = 0; m < 4; ++m) { bf16* rowp = R + (size_t)(row0 + ai * 128 + m * 16) * DFF + col0;
#pragma unroll
                for (int bj = 0; bj < 2; ++bj) { f32x4 v0 = acc[ai][bj][m][0], v1 = acc[ai][bj][m][1];
#pragma unroll
                    for (int e = 0; e < 4; ++e) { const float a = fmaxf(v0[e], 0.f), b = fmaxf(v1[e], 0.f); v0[e] = a * a; v1[e] = b * b; }
                    v4u w; w.x = cvt_pk_bf16(v0[0], v0[1]); w.y = cvt_pk_bf16(v0[2], v0[3]); w.z = cvt_pk_bf16(v1[0], v1[1]); w.w = cvt_pk_bf16(v1[2], v1[3]);
                    *(v4u*)(rowp + bj * 128) = w; } }
    }
};

template <class E>
__device__ __forceinline__ void skinny_phase(LAS unsigned char* lds, const bf16* A, const bf16* Bt, int N, int K, int first, int stride, const E& e) {
    const int tid = threadIdx.x, lane = tid & 63, wave = __builtin_amdgcn_readfirstlane(tid >> 6), fr = lane & 15, fq = lane >> 4;
    const int ksl = K >> 3, nks = ksl >> 5;
    LAS f32x4* red = (LAS f32x4*)lds;
    for (int task = first; task < (N >> 4); task += stride) {
        f32x4 acc[4];
#pragma unroll
        for (int m = 0; m < 4; ++m) acc[m] = (f32x4){0.f, 0.f, 0.f, 0.f};
        const bf16* bp = Bt + (size_t)(task * 16 + fr) * K + wave * ksl + fq * 8;
        const bf16* ap = A + (size_t)fr * K + wave * ksl + fq * 8;
#pragma unroll 4
        for (int ks = 0; ks < nks; ++ks) {
            const bf16x8 b = *(const bf16x8*)(bp + ks * 32);
#pragma unroll
            for (int m = 0; m < 4; ++m) { const bf16x8 a = *(const bf16x8*)(ap + (size_t)(m * 16) * K + ks * 32);
                acc[m] = __builtin_amdgcn_mfma_f32_16x16x32_bf16(a, b, acc[m], 0, 0, 0); }
        }
#pragma unroll
        for (int m = 0; m < 4; ++m) red[(wave * 4 + m) * 64 + lane] = acc[m];
        __syncthreads();
        {
            const int row = tid >> 3, cp = tid & 7; const int m = row >> 4, q = (row & 15) >> 2, j = row & 3;
            float v0 = 0.f, v1 = 0.f;
            const LAS float* rf = (const LAS float*)lds;
#pragma unroll
            for (int w = 0; w < 8; ++w) { v0 += rf[(((w * 4 + m) * 64) + q * 16 + 2 * cp) * 4 + j]; v1 += rf[(((w * 4 + m) * 64) + q * 16 + 2 * cp + 1) * 4 + j]; }
            e(row, task * 16 + 2 * cp, v0, v1);
        }
        __syncthreads();
    }
}
struct SkStore { float* out; int ld; __device__ __forceinline__ void operator()(int r, int c, float v0, float v1) const { *(f32x2*)(out + (size_t)r * ld + c) = (f32x2){v0, v1}; } };
struct SkRes { const float* base; float* out; __device__ __forceinline__ void operator()(int r, int c, float v0, float v1) const { const f32x2 b = *(const f32x2*)(base + (size_t)r * DM + c); *(f32x2*)(out + (size_t)r * DM + c) = (f32x2){b.x * DN_ALPHA + v0, b.y * DN_ALPHA + v1}; } };
struct SkRelu2 { bf16* R; __device__ __forceinline__ void operator()(int r, int c, float v0, float v1) const { const float a = fmaxf(v0, 0.f), b = fmaxf(v1, 0.f); *(unsigned*)(R + (size_t)r * DFF + c) = cvt_pk_bf16(a * a, b * b); } };

__device__ __forceinline__ void transpose_item(const float* W, int K, int N, bf16* WT, int dst_n0, LAS float* scr, int k0, int n0, int lane) {
#pragma unroll 8
    for (int i = 0; i < 32; ++i) { const int kk = 2 * i + (lane >> 5); scr[kk * 33 + (lane & 31)] = W[(size_t)(k0 + kk) * N + n0 + (lane & 31)]; }
    LDS_WAIT(); asm volatile("" ::: "memory");
    const int c = lane & 7;
#pragma unroll
    for (int j = 0; j < 4; ++j) { const int n = (lane >> 3) + 8 * j; const LAS float* s = scr + (8 * c) * 33 + n;
        v4u o; o.x = cvt_pk_bf16(s[0 * 33], s[1 * 33]); o.y = cvt_pk_bf16(s[2 * 33], s[3 * 33]); o.z = cvt_pk_bf16(s[4 * 33], s[5 * 33]); o.w = cvt_pk_bf16(s[6 * 33], s[7 * 33]);
        *(v4u*)(WT + (size_t)(dst_n0 + n) * K + k0 + 8 * c) = o; }
    LDS_WAIT(); asm volatile("" ::: "memory");
}
__device__ __forceinline__ int win_dst(int n0) {
    if (n0 < 3072) return n0;
    if (n0 < 4096) { const int c = n0 - 3072; return 3072 + (c >> 7) * 256 + (c & 127); }
    const int c = n0 - 4096; return 3072 + (c >> 7) * 256 + 128 + (c & 127);
}

template <bool WB>
__device__ __forceinline__ void ln_row(const float* in, float* out, bf16* outb, const float* g, const float* b, int lane) {
    const f32x4* xr = (const f32x4*)in + lane; f32x4 v[8]; float s = 0.f;
#pragma unroll
    for (int j = 0; j < 8; ++j) { v[j] = xr[64 * j]; s += (v[j].x + v[j].y) + (v[j].z + v[j].w); }
    const float mean = wave_sum(s) * (1.f / DM); float s2 = 0.f;
#pragma unroll
    for (int j = 0; j < 8; ++j) { v[j] = v[j] - mean; s2 += (v[j].x * v[j].x + v[j].y * v[j].y) + (v[j].z * v[j].z + v[j].w * v[j].w); }
    const float rstd = 1.f / sqrtf(wave_sum(s2) * (1.f / DM) + LN_EPS);
#pragma unroll
    for (int j = 0; j < 8; ++j) { const f32x4 gg = ((const f32x4*)g)[64 * j + lane], bb = ((const f32x4*)b)[64 * j + lane];
        const f32x4 o = v[j] * rstd * gg + bb; ((f32x4*)out)[64 * j + lane] = o;
        if (WB) { v2u w; w.x = cvt_pk_bf16(o.x, o.y); w.y = cvt_pk_bf16(o.z, o.w); ((v2u*)outb)[64 * j + lane] = w; } }
}

template <class LD>
__device__ __forceinline__ void conv_item(const LD& ld, int nch, const float* w_dw, const float* b_dw, const float* lg, const float* lb, bf16* mix0, LAS float* red, int tid, int lane, int wave) {
    const int c = tid * 2;
    f32x2 w[31];
#pragma unroll
    for (int j = 0; j < 31; ++j) w[j] = *(const f32x2*)(w_dw + j * 1024 + c);
    const f32x2 bias = *(const f32x2*)(b_dw + c), gg = *(const f32x2*)(lg + c), bb = *(const f32x2*)(lb + c);
    f32x2 win[38];
#pragma unroll
    for (int i = 0; i < 30; ++i) win[i] = ld(i, c);
#pragma nounroll
    for (int ch = 0; ch < nch; ++ch) {
#pragma unroll
        for (int k = 0; k < 8; ++k) win[30 + k] = ld(30 + 8 * ch + k, c);
        f32x2 acc[8];
#pragma unroll
        for (int tt = 0; tt < 8; ++tt) { f32x2 a = bias;
#pragma unroll
            for (int j = 0; j < 31; ++j) a += win[tt + j] * w[j];
            acc[tt] = a; }
        LAS float* rb = red + (ch & 1) * 128;
#pragma unroll
        for (int tt = 0; tt < 8; ++tt) { const float s1 = wave_sum(acc[tt].x + acc[tt].y), s2 = wave_sum(acc[tt].x * acc[tt].x + acc[tt].y * acc[tt].y);
            if (lane == 0) *(LAS f32x2*)(rb + (tt * 8 + wave) * 2) = (f32x2){s1, s2}; }
        __syncthreads();
        const f32x2 pr = *(const LAS f32x2*)(rb + lane * 2);
        const float t1 = sum8(pr.x), t2 = sum8(pr.y);
#pragma unroll
        for (int tt = 0; tt < 8; ++tt) { const float s1 = rdlane(t1, tt * 8), s2 = rdlane(t2, tt * 8);
            const float mean = s1 * (1.f / 1024.f), var = s2 * (1.f / 1024.f) - mean * mean, rstd = 1.f / sqrtf(fmaxf(var, 0.f) + LN_EPS);
            f32x2 y = (acc[tt] - mean) * rstd * gg + bb;
            y.x = y.x * sigmoidf_(y.x); y.y = y.y * sigmoidf_(y.y);
            *(unsigned*)(mix0 + (size_t)(ch * 8 + tt) * DM + c) = cvt_pk_bf16(y.x, y.y); }
#pragma unroll
        for (int i = 0; i < 30; ++i) win[i] = win[i + 8];
    }
    __syncthreads();
}
struct LdPrompt { const float* U; int b, t0;
    __device__ __forceinline__ f32x2 operator()(int i, int c) const { const int pos = t0 - 30 + i; if (pos < 0) return (f32x2){0.f, 0.f}; return *(const f32x2*)(U + (size_t)(b * 2048 + pos) * 1024 + c); } };
struct LdSample { const float* state; const float* PS; float* convs; int n;
    __device__ __forceinline__ f32x2 operator()(int i, int c) const {
        if (i < 30) return *(const f32x2*)(state + (size_t)(n * 30 + i) * 1024 + c);
        const float* pr = PS + (size_t)(n * 8 + i - 30) * DIN + 3072 + (c >> 7) * 256 + (c & 127);
        const f32x2 a = *(const f32x2*)pr, g = *(const f32x2*)(pr + 128);
        const f32x2 u = (f32x2){a.x * sigmoidf_(g.x), a.y * sigmoidf_(g.y)};
        *(f32x2*)(convs + (size_t)(n * 30 + i - 8) * 1024 + c) = u;
        return u; } };

__device__ __forceinline__ void attn_item(LAS unsigned char* lds, const bf16* QB, const bf16* KB, const bf16* VB, bf16* OP, float* LSE, int it, int tid, int lane, int wave) {
    const int bh = it / 48, rem = it - bh * 48, p = rem >> 4, idx = rem & 15;
    const int b = bh >> 3, h = bh & 7, dil = 1 << (2 * p);
    const int cls = p == 0 ? 0 : (p == 1 ? (idx & 3) : idx), blk = p == 0 ? idx : (p == 1 ? (idx >> 2) : 0);
    const int kb0 = blk == 0 ? 8 : 0;
    const int fr = lane & 15, fq = lane >> 4;
    {
        v4u kr[8], vr[8]; const int row0 = tid >> 4, ch = tid & 15;
#pragma unroll
        for (int i = 0; i < 8; ++i) if (i >= (kb0 >> 1)) { const int row = row0 + 32 * i; const size_t tok = (size_t)(b * 2048 + (blk * 128 - 128 + row) * dil + cls);
            kr[i] = *(const v4u*)(KB + tok * 1024 + h * 128 + ch * 8); vr[i] = *(const v4u*)(VB + tok * 1024 + h * 128 + ch * 8); }
#pragma unroll
        for (int i = 0; i < 8; ++i) if (i >= (kb0 >> 1)) { const int row = row0 + 32 * i;
            *(LAS v4u*)(lds + ATT_KOFF + row * ATT_KSTR + ch * 16) = kr[i]; *(LAS v4u*)(lds + ATT_VOFF + row * ATT_VSTR + ch * 16) = vr[i]; }
    }
    const int qi = wave * 16 + fr;
    const size_t tq = (size_t)(b * 2048 + (blk * 128 + qi) * dil + cls);
    bf16x8 qf[4];
#pragma unroll
    for (int ks = 0; ks < 4; ++ks) qf[ks] = *(const bf16x8*)(QB + tq * 1024 + h * 128 + ks * 32 + fq * 8);
    __syncthreads();
    f32x4 S[9];
#pragma unroll
    for (int kk = 0; kk < 9; ++kk) { const int kb = wave + kk; f32x4 a = (f32x4){0.f, 0.f, 0.f, 0.f};
#pragma unroll
        for (int ks = 0; ks < 4; ++ks) { const bf16x8 kf = *(const LAS bf16x8*)(lds + ATT_KOFF + (kb * 16 + fr) * ATT_KSTR + (ks * 32 + fq * 8) * 2);
            a = __builtin_amdgcn_mfma_f32_16x16x32_bf16(kf, qf[ks], a, 0, 0, 0); }
        S[kk] = a; }
    float mx = -INFINITY;
#pragma unroll
    for (int kk = 0; kk < 9; ++kk) { const int kb = wave + kk;
#pragma unroll
        for (int j = 0; j < 4; ++j) { const int kidx = kb * 16 + fq * 4 + j; const bool valid = (kidx >= qi) && (kidx <= qi + 128) && (kb >= kb0);
            const float s = valid ? S[kk][j] * SC2 : -INFINITY; S[kk][j] = s; mx = fmaxf(mx, s); } }
    mx = fmaxf(mx, __shfl_xor(mx, 16)); mx = fmaxf(mx, __shfl_xor(mx, 32));
    float l = 0.f;
#pragma unroll
    for (int kk = 0; kk < 9; ++kk)
#pragma unroll
        for (int j = 0; j < 4; ++j) { const float e = fast_exp2(S[kk][j] - mx); S[kk][j] = e; l += e; }
    l += __shfl_xor(l, 16); l += __shfl_xor(l, 32);
    bf16x8 pf[5];
#pragma unroll
    for (int s = 0; s < 5; ++s) { v4u w; w.x = cvt_pk_bf16(S[2 * s][0], S[2 * s][1]); w.y = cvt_pk_bf16(S[2 * s][2], S[2 * s][3]);
        if (s < 4) { w.z = cvt_pk_bf16(S[2 * s + 1][0], S[2 * s + 1][1]); w.w = cvt_pk_bf16(S[2 * s + 1][2], S[2 * s + 1][3]); } else { w.z = 0u; w.w = 0u; }
        pf[s] = __builtin_bit_cast(bf16x8, w); }
    const float rl = 1.0f / l;
    bf16* orow = OP + (size_t)p * ((size_t)MP * 1024) + tq * 1024 + h * 128;
#pragma unroll
    for (int db = 0; db < 8; ++db) { f32x4 o = (f32x4){0.f, 0.f, 0.f, 0.f};
#pragma unroll
        for (int s = 0; s < 5; ++s) { int kbA = wave + 2 * s, kbB = wave + 2 * s + 1; kbA = kbA < kb0 ? kb0 : kbA; kbB = kbB < kb0 ? kb0 : (kbB > 15 ? 15 : kbB);
            const s16x4 r1 = __builtin_bit_cast(s16x4, __builtin_amdgcn_ds_read_tr16_b64_v4i16((LAS s16x4*)(lds + ATT_VOFF + (kbA * 16 + fq * 4 + (fr >> 2)) * ATT_VSTR + (db * 16 + 4 * (fr & 3)) * 2)));
            const s16x4 r2 = __builtin_bit_cast(s16x4, __builtin_amdgcn_ds_read_tr16_b64_v4i16((LAS s16x4*)(lds + ATT_VOFF + (kbB * 16 + fq * 4 + (fr >> 2)) * ATT_VSTR + (db * 16 + 4 * (fr & 3)) * 2)));
            const bf16x8 vf = (bf16x8){r1[0], r1[1], r1[2], r1[3], r2[0], r2[1], r2[2], r2[3]};
            o = __builtin_amdgcn_mfma_f32_16x16x32_bf16(vf, pf[s], o, 0, 0, 0); }
        v2u w; w.x = cvt_pk_bf16(o[0] * rl, o[1] * rl); w.y = cvt_pk_bf16(o[2] * rl, o[3] * rl);
        *(v2u*)(orow + db * 16 + fq * 4) = w; }
    if (fq == 0) LSE[(size_t)p * (MP * 8) + tq * 8 + h] = mx + __builtin_amdgcn_logf(l);
    __syncthreads();
}

__device__ __forceinline__ void sattn_block(LAS float* sm, const float* PS, const float* ck, const float* cv, bf16* MIXS, float* kws, float* vws, int bi, int tid, int lane, int wave) {
    const int n = bi >> 5, t = (bi >> 2) & 7, hp = bi & 3;
    const float* prow = PS + (size_t)(n * 8 + t) * DIN;
    if (wave < 6) {
        const int h = hp * 2 + (wave >= 3 ? 1 : 0), p = wave >= 3 ? wave - 3 : wave;
        const int grp = lane >> 4, sub = lane & 15;
        const f32x4 q0 = *(const f32x4*)(prow + h * 128 + sub * 8), q1 = *(const f32x4*)(prow + h * 128 + sub * 8 + 4);
        LAS float* ssc = sm + 8 * 136 + wave * 132;
        float m = -INFINITY;
#pragma nounroll
        for (int bt = 0; bt < 3; ++bt) { f32x4 k0[11], k1[11];
#pragma unroll
            for (int i = 0; i < 11; ++i) { const int j = (bt * 11 + i) * 4 + grp, jc = j > 128 ? 128 : j; const int e = 2048 + t - (jc << (2 * p));
                const float* kr = (e < 2048) ? ck + ((size_t)(n * 2048 + e) * 8 + h) * 128 : PS + (size_t)(n * 8 + e - 2048) * DIN + 1024 + h * 128;
                k0[i] = *(const f32x4*)(kr + sub * 8); k1[i] = *(const f32x4*)(kr + sub * 8 + 4); }
#pragma unroll
            for (int i = 0; i < 11; ++i) { const int j = (bt * 11 + i) * 4 + grp;
                float d = (q0.x * k0[i].x + q0.y * k0[i].y) + (q0.z * k0[i].z + q0.w * k0[i].w) + (q1.x * k1[i].x + q1.y * k1[i].y) + (q1.z * k1[i].z + q1.w * k1[i].w);
                d = row16_sum(d); const float sv = j <= 128 ? d * SC2 : -INFINITY; m = fmaxf(m, sv);
                if (sub == 0) ssc[(bt * 11 + i) * 4 + grp] = sv; } }
        m = fmaxf(m, __shfl_xor(m, 16)); m = fmaxf(m, __shfl_xor(m, 32));
        LDS_WAIT(); asm volatile("" ::: "memory");
        float l = 0.f; f32x4 o0 = (f32x4){0.f, 0.f, 0.f, 0.f}, o1 = o0;
#pragma nounroll
        for (int bt = 0; bt < 3; ++bt) { f32x4 v0[11], v1[11];
#pragma unroll
            for (int i = 0; i < 11; ++i) { const int j = (bt * 11 + i) * 4 + grp, jc = j > 128 ? 128 : j; const int e = 2048 + t - (jc << (2 * p));
                const float* vr = (e < 2048) ? cv + ((size_t)(n * 2048 + e) * 8 + h) * 128 : PS + (size_t)(n * 8 + e - 2048) * DIN + 2048 + h * 128;
                v0[i] = *(const f32x4*)(vr + sub * 8); v1[i] = *(const f32x4*)(vr + sub * 8 + 4); }
#pragma unroll
            for (int i = 0; i < 11; ++i) { const float pw = fast_exp2(ssc[(bt * 11 + i) * 4 + grp] - m); l += pw; o0 += v0[i] * pw; o1 += v1[i] * pw; } }
        l += __shfl_xor(l, 16); l += __shfl_xor(l, 32);
#pragma unroll
        for (int e = 0; e < 4; ++e) { o0[e] += __shfl_xor(o0[e], 16); o0[e] += __shfl_xor(o0[e], 32); o1[e] += __shfl_xor(o1[e], 16); o1[e] += __shfl_xor(o1[e], 32); }
        LAS float* w = sm + wave * 136;
        if (lane == 0) { w[0] = m; w[1] = l; }
        if (grp == 0) { *(LAS f32x4*)(w + 8 + sub * 8) = o0; *(LAS f32x4*)(w + 8 + sub * 8 + 4) = o1; }
    }
    __syncthreads();
    if (tid < 256) { const int ii = tid >> 7, d = tid & 127, h = hp * 2 + ii; const LAS float* w = sm + ii * 3 * 136;
        const float m0 = w[0], m1 = w[136], m2 = w[272], M = fmaxf(m0, fmaxf(m1, m2));
        const float e0 = fast_exp2(m0 - M), e1 = fast_exp2(m1 - M), e2 = fast_exp2(m2 - M);
        const float L = w[1] * e0 + w[137] * e1 + w[273] * e2;
        const float o = (w[8 + d] * e0 + w[136 + 8 + d] * e1 + w[272 + 8 + d] * e2) / L;
        MIXS[(size_t)(n * 8 + t) * DM + h * 128 + d] = (bf16)(cvt_pk_bf16(o, 0.f) & 0xffffu);
        const size_t orow = ((size_t)(n * 2048 + 2040 + t) * 8 + h) * 128 + d;
        kws[orow] = prow[1024 + h * 128 + d]; vws[orow] = prow[2048 + h * 128 + d]; }
    __syncthreads();
}

#define XB_TMO      128
#define XB_XCNT(j)  (256  + 64 * (j))
#define XB_XSUB(j)  (1280 + 64 * (j))
#define XB_XGEN(j)  (2304 + 64 * (j))
#define XB_TOP      3328
#define XB_TOPGEN   3392
#define XCD_BAR_WORDS 3456
#define XB_SPIN_CAP (1u << 18)

__device__ __forceinline__ unsigned xb_ld(unsigned* p)              { return __hip_atomic_load(p, __ATOMIC_RELAXED, __HIP_MEMORY_SCOPE_AGENT); }
__device__ __forceinline__ unsigned xb_add(unsigned* p, unsigned v) { return __hip_atomic_fetch_add(p, v, __ATOMIC_RELAXED, __HIP_MEMORY_SCOPE_AGENT); }
__device__ __forceinline__ unsigned xb_xcc_id() { return (unsigned)__builtin_amdgcn_s_getreg((3 << 11) | 20) & 0xFu; }
#define XB_SPIN(cond, bar) do { unsigned _sp = 0; while (cond) { __builtin_amdgcn_s_sleep(1); \
    if ((++_sp & 255u) == 0u) { if (xb_ld(&(bar)[XB_TMO])) break; if (_sp > XB_SPIN_CAP) { atomicAdd(&(bar)[XB_TMO], 1u); break; } } } } while (0)

struct XcdBarrier {
    unsigned* bar; unsigned x;
    volatile LAS unsigned* st;
};

__device__ __forceinline__ XcdBarrier xcd_barrier_post(unsigned* bar, volatile LAS unsigned* st) {
    XcdBarrier b; b.bar = bar; b.x = xb_xcc_id(); b.st = st;
    if (threadIdx.x == 0) (void)xb_add(&bar[XB_XCNT(b.x)], 1u);
    return b;
}
__device__ __forceinline__ void xcd_barrier_complete(unsigned* bar, unsigned x, unsigned& nloc, unsigned& nx) {
    const unsigned G = gridDim.x * gridDim.y * gridDim.z;
    unsigned sum, cnt, mine, sp = 0u;
    for (;;) {
        sum = 0u; cnt = 0u; mine = 0u;
#pragma unroll
        for (unsigned j = 0; j < 16; ++j) { const unsigned c = xb_ld(&bar[XB_XCNT(j)]); sum += c; cnt += (c > 0u) ? 1u : 0u; mine = (j == x) ? c : mine; }
        if (sum == G) break;
        __builtin_amdgcn_s_sleep(1);
        if ((++sp & 255u) == 0u) { if (xb_ld(&bar[XB_TMO])) break; if (sp > XB_SPIN_CAP) { atomicAdd(&bar[XB_TMO], 1u); break; } }
    }
    nloc = mine > 0u ? mine : 1u; nx = cnt > 0u ? cnt : 1u;
}

__device__ __forceinline__ void xcd_barrier(const XcdBarrier& b) {
    asm volatile("s_waitcnt vmcnt(0)" ::: "memory");
    __syncthreads();
    if (threadIdx.x == 0) {
        unsigned* bar = b.bar;
        __builtin_amdgcn_s_waitcnt(0);
        unsigned nloc = b.st[0], nx = b.st[1];
        if (nloc == 0u) { xcd_barrier_complete(bar, b.x, nloc, nx); b.st[0] = nloc; b.st[1] = nx; }
        const unsigned old = xb_add(&bar[XB_XSUB(b.x)], 1u);
        const unsigned gen = old / nloc;
        if (old + 1u == (gen + 1u) * nloc) {
            __builtin_amdgcn_fence(__ATOMIC_RELEASE, "agent");
            asm volatile("s_waitcnt vmcnt(0)" ::: "memory");
            const unsigned og = xb_add(&bar[XB_TOP], 1u);
            const unsigned tg = og / nx;
            if (og + 1u == (tg + 1u) * nx) xb_add(&bar[XB_TOPGEN], 1u);
            else XB_SPIN(xb_ld(&bar[XB_TOPGEN]) == tg, bar);
            __builtin_amdgcn_fence(__ATOMIC_ACQUIRE, "agent");
            xb_add(&bar[XB_XGEN(b.x)], 1u);
            asm volatile("s_waitcnt vmcnt(0)" ::: "memory");
        } else {
            XB_SPIN(xb_ld(&bar[XB_XGEN(b.x)]) == gen, bar);
            __builtin_amdgcn_fence(__ATOMIC_ACQUIRE, "agent");
            asm volatile("s_waitcnt vmcnt(0)" ::: "memory");
        }
    }
    __syncthreads();
}

struct Args { const float* in[17]; float* out; unsigned char* ws; int ph_lo, ph_hi; };
__global__ void __launch_bounds__(512, 2) fwd_kernel(Args args) {
    extern __shared__ __attribute__((aligned(16))) unsigned char lds_raw[];
    LAS unsigned char* lds = (LAS unsigned char*)lds_raw;
    const int tid = threadIdx.x, lane = tid & 63, wave = __builtin_amdgcn_readfirstlane(tid >> 6);
    const int G = gridDim.x, bx = blockIdx.x;
    const int vb = (G % 8 == 0) ? (bx % 8) * (G / 8) + bx / 8 : bx;
    const int gtid = vb * 512 + tid, NT = G * 512;
    const int gw = vb * 8 + wave, NGW = G * 8;
    cg::grid_group grid = cg::this_grid();
    volatile LAS unsigned* MISC = (volatile LAS unsigned*)(lds + LDS_BYTES - 64);
    if (tid < 16) MISC[tid] = 0u;
    __syncthreads();
    XcdBarrier bar = xcd_barrier_post((unsigned*)(args.ws) + 4096, MISC + 8);
    if (args.ph_lo > args.ph_hi) grid.sync();
    const int lo = args.ph_lo, hi = args.ph_hi;
#ifndef REP_MASK
#define REP_MASK 0
#endif
#ifndef EXTRA_SYNCS
#define EXTRA_SYNCS 0
#endif
#define REPS(k) _Pragma("nounroll") for (int rep_ = 0; rep_ < 1 + ((REP_MASK >> (k)) & 1); ++rep_)
#ifndef PH_MASK
#define PH_MASK 0x7FF
#endif
#define IN(k) (((PH_MASK >> (k)) & 1) && lo <= (k) && (k) < hi)
#define SEAM(k) do { if (IN(k) && IN((k) + 1)) xcd_barrier(bar); } while (0)
    unsigned char* ws = args.ws; float* out = args.out;
    const float* x_prompt = args.in[0]; const float* x_sample = args.in[1]; const float* cache_k = args.in[2]; const float* cache_v = args.in[3]; const float* state_conv = args.in[4];
    const float* w_in = args.in[5]; const float* w_dw = args.in[6]; const float* b_dw = args.in[7]; const float* lncg = args.in[8]; const float* lncb = args.in[9];
    const float* w_out = args.in[10]; const float* ln1g = args.in[11]; const float* ln1b = args.in[12]; const float* w_up = args.in[13]; const float* w_down = args.in[14];
    const float* ln2g = args.in[15]; const float* ln2b = args.in[16];
    bf16* WIN = (bf16*)(ws + WS_WIN); bf16* WOUT = (bf16*)(ws + WS_WOUT); bf16* WUP = (bf16*)(ws + WS_WUP); bf16* WDN = (bf16*)(ws + WS_WDN);
    float* T1 = (float*)(ws + WS_T1); bf16* HB = (bf16*)(ws + WS_HB);
    bf16* XS = (bf16*)(ws + WS_XS); bf16* MIXS = (bf16*)(ws + WS_MIXS); bf16* HBS = (bf16*)(ws + WS_HBS); float* T1S = (float*)(ws + WS_T1S); float* PS = (float*)(ws + WS_PS); bf16* RS = (bf16*)(ws + WS_RS);
    bf16* XB = (bf16*)(ws + WS_XB); bf16* MIXED = (bf16*)(ws + WS_XB); bf16* QB = (bf16*)(ws + WS_QB); bf16* KB = (bf16*)(ws + WS_KB); bf16* VB = (bf16*)(ws + WS_VB);
    float* U = (float*)(ws + WS_U); bf16* OP = (bf16*)(ws + WS_OP); float* LSE = (float*)(ws + WS_LSE); bf16* R = (bf16*)(ws + WS_R);

    if (IN(0)) {
        LAS float* scr = (LAS float*)(lds + wave * 8448);
        constexpr int I_IN = 32 * 160, I_OUT = 32 * 64, I_UP = 32 * 256, I_DN = 128 * 64;
        for (int it = gw; it < I_IN + I_OUT + I_UP + I_DN; it += NGW) {
            int r = it;
            if (r < I_IN) { const int kb = r / 160, nb = r % 160; transpose_item(w_in, DM, DIN, WIN, win_dst(32 * nb), scr, 64 * kb, 32 * nb, lane); continue; } r -= I_IN;
            if (r < I_OUT) { const int kb = r / 64, nb = r % 64; transpose_item(w_out, DM, DM, WOUT, 32 * nb, scr, 64 * kb, 32 * nb, lane); continue; } r -= I_OUT;
            if (r < I_UP) { const int kb = r / 256, nb = r % 256; transpose_item(w_up, DM, DFF, WUP, 32 * nb, scr, 64 * kb, 32 * nb, lane); continue; } r -= I_UP;
            { const int kb = r / 64, nb = r % 64; transpose_item(w_down, DFF, DM, WDN, 32 * nb, scr, 64 * kb, 32 * nb, lane); }
        }
        for (int i = gtid; i < MP * DM / 8; i += NT) { const f32x4 a = ((const f32x4*)x_prompt)[2 * i], b = ((const f32x4*)x_prompt)[2 * i + 1];
            v4u o; o.x = cvt_pk_bf16(a.x, a.y); o.y = cvt_pk_bf16(a.z, a.w); o.z = cvt_pk_bf16(b.x, b.y); o.w = cvt_pk_bf16(b.z, b.w); ((v4u*)XB)[i] = o; }
        for (int i = gtid; i < MS * DM / 8; i += NT) { const f32x4 a = ((const f32x4*)x_sample)[2 * i], b = ((const f32x4*)x_sample)[2 * i + 1];
            v4u o; o.x = cvt_pk_bf16(a.x, a.y); o.y = cvt_pk_bf16(a.z, a.w); o.z = cvt_pk_bf16(b.x, b.y); o.w = cvt_pk_bf16(b.z, b.w); ((v4u*)XS)[i] = o; }
        {
            const f32x4* sk = (const f32x4*)cache_k; const f32x4* sv = (const f32x4*)cache_v; f32x4* dk = (f32x4*)(out + O_KS); f32x4* dv = (f32x4*)(out + O_VS);
            for (int i = gtid; i < 8 * 522240; i += NT) { const int n = i / 522240, r = i - n * 522240; const size_t d = (size_t)n * 524288 + r;
                dk[d] = sk[d + 2048]; dv[d] = sv[d + 2048]; }
            const f32x4* ss = (const f32x4*)state_conv; f32x4* dc = (f32x4*)(out + O_CS);
            for (int i = gtid; i < 8 * 5632; i += NT) { const int n = i / 5632, r = i - n * 5632; dc[(size_t)n * 7680 + r] = ss[(size_t)n * 7680 + 2048 + r]; }
        }
    }
    SEAM(0);
    for (int es_ = 0; es_ < EXTRA_SYNCS; ++es_) xcd_barrier(bar);
    if (IN(1)) {
        pg8::Gemm g{XB, WIN, MP, DIN, DM}; pg8::StaticOrder S; S.init(MP, DIN, G, bx);
        EpiG1 E{QB, U, out + O_KP, out + O_CP};
        pg8::gemm_phase<EpiG1, pg8::StaticOrder, true, true>(lds, g, S, E);
        skinny_phase(lds, XS, WIN, DIN, DM, (G == 256) ? (bx >= 128 ? bx - 128 : (1 << 30)) : vb, (G == 256) ? 128 : G, SkStore{PS, DIN});
    }
    SEAM(1);
    if (IN(2)) {
        for (int it = bx; it < 1536; it += G) attn_item(lds, QB, KB, VB, OP, LSE, it, tid, lane, wave);
    }
    if (IN(3)) {
        for (int it = bx; it < 264; it += G) {
            if (it < 256) { const int b = it >> 6, t0 = (it & 63) * 32;
                conv_item(LdPrompt{U, b, t0}, 4, w_dw, b_dw, lncg, lncb, MIXED + (size_t)(b * 2048 + t0) * DM + 1024, (LAS float*)lds, tid, lane, wave); }
            else { const int n = it - 256;
                conv_item(LdSample{state_conv, PS, out + O_CS, n}, 1, w_dw, b_dw, lncg, lncb, MIXS + (size_t)(n * 8) * DM + 1024, (LAS float*)lds, tid, lane, wave); }
        }
    }
    if (IN(4)) {
        for (int it = G - 1 - bx; it < 256; it += G) sattn_block((LAS float*)(lds + 4096), PS, cache_k, cache_v, MIXS, out + O_KS, out + O_VS, it, tid, lane, wave);
    }
    SEAM(4);
    if (IN(5)) {
        for (int i = gtid; i < MP * 128; i += NT) { const int tok = i >> 7, h = (i >> 4) & 7, ch = i & 15;
            const float l0 = LSE[(size_t)tok * 8 + h], l1 = LSE[(size_t)MP * 8 + (size_t)tok * 8 + h], l2 = LSE[(size_t)2 * MP * 8 + (size_t)tok * 8 + h];
            const float m = fmaxf(l0, fmaxf(l1, l2)); float w0 = fast_exp2(l0 - m), w1 = fast_exp2(l1 - m), w2 = fast_exp2(l2 - m); const float inv = 1.0f / (w0 + w1 + w2); w0 *= inv; w1 *= inv; w2 *= inv;
            const size_t off = (size_t)tok * 1024 + h * 128 + ch * 8;
            const v4u a0 = *(const v4u*)(OP + off), a1 = *(const v4u*)(OP + (size_t)MP * 1024 + off), a2 = *(const v4u*)(OP + (size_t)2 * MP * 1024 + off);
            v4u o;
#pragma unroll
            for (int e = 0; e < 4; ++e) { const float lo_ = w0 * __uint_as_float(a0[e] << 16) + w1 * __uint_as_float(a1[e] << 16) + w2 * __uint_as_float(a2[e] << 16);
                const float hi_ = w0 * __uint_as_float(a0[e] & 0xffff0000u) + w1 * __uint_as_float(a1[e] & 0xffff0000u) + w2 * __uint_as_float(a2[e] & 0xffff0000u);
                o[e] = cvt_pk_bf16(lo_, hi_); }
            *(v4u*)(MIXED + (size_t)tok * DM + h * 128 + ch * 8) = o; }
    }
    SEAM(5);
    if (IN(6)) {
        pg8::Gemm g{MIXED, WOUT, MP, DM, DM}; pg8::StaticOrder S; S.init(MP, DM, G, bx);
        EpiRes E{x_prompt, T1};
        pg8::gemm_phase<EpiRes, pg8::StaticOrder, true, true>(lds, g, S, E);
        skinny_phase(lds, MIXS, WOUT, DM, DM, vb, G, SkRes{x_sample, T1S});
    }
    SEAM(6);
    if (IN(7)) {
        for (int r = gw; r < MP + MS; r += NGW) {
            if (r < MP) ln_row<true>(T1 + (size_t)r * DM, T1 + (size_t)r * DM, HB + (size_t)r * DM, ln1g, ln1b, lane);
            else { const int rs = r - MP; ln_row<true>(T1S + (size_t)rs * DM, T1S + (size_t)rs * DM, HBS + (size_t)rs * DM, ln1g, ln1b, lane); }
        }
    }
    SEAM(7);
    if (IN(8)) {
        pg8::Gemm g{HB, WUP, MP, DFF, DM}; pg8::StaticOrder S; S.init(MP, DFF, G, bx);
        EpiRelu2 E{R};
        pg8::gemm_phase<EpiRelu2, pg8::StaticOrder, true, true>(lds, g, S, E);
        skinny_phase(lds, HBS, WUP, DFF, DM, vb, G, SkRelu2{RS});
    }
    SEAM(8);
    if (IN(9)) {
        pg8::Gemm g{R, WDN, MP, DM, DFF}; pg8::StaticOrder S; S.init(MP, DM, G, bx);
        EpiRes E{T1, out + O_YP};
        pg8::gemm_phase<EpiRes, pg8::StaticOrder, true, true>(lds, g, S, E);
        skinny_phase(lds, RS, WDN, DM, DFF, vb, G, SkRes{T1S, out + O_YS});
    }
    SEAM(9);
    if (IN(10)) {
        for (int r = gw; r < MP + MS; r += NGW) { float* yr = out + (size_t)r * DM;
            ln_row<false>(yr, yr, nullptr, ln2g, ln2b, lane); }
    }
#undef IN
#undef SEAM
}

extern "C" void kernel_launch(void* const* d_in, const int* in_sizes, int n_in, void* d_out, int out_size, void* d_ws, size_t ws_size, hipStream_t stream) {
    static int grid = 0;
    if (grid == 0) {
        if (n_in != 17 || (size_t)out_size != O_END || ws_size < WS_END) { fprintf(stderr, "kernel_launch: unexpected shapes (n_in %d out %d ws %zu)\n", n_in, out_size, ws_size); grid = -1; return; }
        int dev = 0, cus = 0, per_cu = 0;
        hipGetDevice(&dev); hipDeviceGetAttribute(&cus, hipDeviceAttributeMultiprocessorCount, dev);
        if (hipFuncSetAttribute((const void*)fwd_kernel, hipFuncAttributeMaxDynamicSharedMemorySize, LDS_BYTES) != hipSuccess) { fprintf(stderr, "kernel_launch: hipFuncSetAttribute failed\n"); grid = -1; return; }
        if (hipOccupancyMaxActiveBlocksPerMultiprocessor(&per_cu, (const void*)fwd_kernel, 512, LDS_BYTES) != hipSuccess || per_cu < 1) { fprintf(stderr, "kernel_launch: occupancy query gave %d\n", per_cu); per_cu = 1; }
        (void)hipGetLastError();
        grid = cus * 1;
    }
    if (grid < 0) return;
    Args a{};
    for (int i = 0; i < 17; ++i) a.in[i] = (const float*)d_in[i];
    a.out = (float*)d_out; a.ws = (unsigned char*)d_ws;
#ifndef LAUNCH_PROG
#define LAUNCH_PROG {0, N_PHASES}
#endif
    static const int prog[] = LAUNCH_PROG;
    for (unsigned li = 0; li + 1 < sizeof(prog) / sizeof(int); li += 2) {
        a.ph_lo = prog[li]; a.ph_hi = prog[li + 1];
        (void)hipMemsetAsync(d_ws, 0, 65536, stream);
        void* kargs[] = {&a};
        hipError_t e = hipLaunchCooperativeKernel((const void*)fwd_kernel, dim3(grid), dim3(512), kargs, LDS_BYTES, stream);
        if (e != hipSuccess) fprintf(stderr, "cooperative launch failed: %s (grid %d)\n", hipGetErrorString(e), grid);
    }
}
```

```cpp
#include <hip/hip_runtime.h>
#include <hip/hip_cooperative_groups.h>
#include <cstdio>
#include <cstdint>
namespace cg = cooperative_groups;
namespace pg8 {
#define PG8_LAS __attribute__((address_space(3)))
typedef unsigned short bf16_t;
typedef short bf16x8 __attribute__((ext_vector_type(8)));
typedef float f32x4 __attribute__((ext_vector_type(4)));
typedef unsigned u32x4 __attribute__((ext_vector_type(4)));
constexpr int BM = 256, BK = 64, HALF = 128, HTB = HALF * BK * 2  , STAGE_BYTES = 8 * HTB, NXCD = 8, WGM = 8;

__host__ __device__ __forceinline__ int lds_byte(int r, int c) { const int st = (r >> 4) * 2 + (c >> 5), rr = r & 15, cc = c & 31, ob = rr * 64 + cc * 2; return st * 1024 + (ob ^ (((ob >> 9) & 1) << 5)); }
__host__ __device__ __forceinline__ void stage_rc(int b, int& R, int& C) { const int st = b / 1024, sb = b % 1024, swz = sb ^ (((sb >> 9) & 1) << 5); R = (st >> 1) * 16 + swz / 64; C = (st & 1) * 32 + (swz % 64) / 2; }
__host__ __device__ __forceinline__ int perm32(int rho) { const int n = rho >> 4, i = rho & 15; return 8 * (i >> 2) + 4 * n + (i & 3); }

struct Unit { int pm, pn; };
struct Gemm { const bf16_t* A; const bf16_t* Bt; int M, N, K; };

struct StaticOrder {
    int nM, nN, nwg, G, c;
    __host__ __device__ void init(int M, int N, int G_, int c_) { nM = M / BM; nN = N / BM; nwg = nM * nN; G = G_; c = c_; }
    __host__ __device__ bool next(int i, Unit& u) const {
        const long L = (long)i * G + c; if (L >= nwg) return false;
        int wgid = (int)L; { const int q = nwg / NXCD, r = nwg % NXCD, xcd = wgid % NXCD, off = wgid / NXCD; wgid = (xcd < r ? xcd * (q + 1) : r * (q + 1) + (xcd - r) * q) + off; }
        const int nig = WGM * nN, gid = wgid / nig, fm = gid * WGM, gsz = (nM - fm) < WGM ? (nM - fm) : WGM;
        u.pm = fm + ((wgid % nig) % gsz); u.pn = (wgid % nig) / gsz; return true;
    }
    __device__ __forceinline__ void a_ready(const Unit&) const {}
    __device__ __forceinline__ void done(const Unit&) const {}
};

__device__ __forceinline__ unsigned cvt_pk_bf16(float lo, float hi) { unsigned r; asm volatile("v_cvt_pk_bf16_f32 %0, %1, %2" : "=v"(r) : "v"(lo), "v"(hi)); return r; }
template <class Epi, class Sched, bool ALIGN_EPI = false, bool SP2 = false>
__device__ __forceinline__ void gemm_phase(PG8_LAS unsigned char* lds, const Gemm g, const Sched& S, const Epi& E) {
    const int tid = threadIdx.x, wid = __builtin_amdgcn_readfirstlane(tid >> 6), lane = tid & 63, wr = wid >> 2, wc = wid & 3, fr = lane & 15, fq = lane >> 4;
    const int K = g.K, nt = K / BK;
    unsigned voffA[2], voffB[2];
#pragma unroll
    for (int i = 0; i < 2; ++i) { int R, C; stage_rc(tid * 16 + i * 8192, R, C); const int Rb = Epi::PERM ? ((R & ~31) + perm32(R & 31)) : R;
        voffA[i] = (unsigned)(R * K + C) * 2u; voffB[i] = (unsigned)(Rb * K + C) * 2u; }
    const size_t kstep = (size_t)(BK * 2);
    const size_t hstep = (size_t)HALF * K * 2;
    const size_t tstep = 2 * hstep;
    const unsigned ldsw = (unsigned)wid * 1024u;
    const int aoff = lds_byte(wr * 64 + fr, fq * 8), boff = lds_byte(wc * 32 + fr, fq * 8);
#define PG8_SA(b, h) (((b) * 2 + (h)) * HTB)
#define PG8_SB(b, h) ((4 + (b) * 2 + (h)) * HTB)
#define PG8_STAGE(bufoff, gbase, voff) do { _Pragma("unroll") for (int _i = 0; _i < 2; ++_i) \
        __builtin_amdgcn_global_load_lds((const unsigned*)((const char*)(gbase) + (voff)[_i]), (PG8_LAS unsigned*)(lds + (bufoff) + ldsw + _i * 8192), 16, 0, 0); } while (0)
#define PG8_LDA(dst, b, h) do { _Pragma("unroll") for (int m = 0; m < 4; ++m) _Pragma("unroll") for (int k = 0; k < 2; ++k) dst[m][k] = *(const PG8_LAS bf16x8*)(lds + PG8_SA(b, h) + aoff + m * 2048 + k * 1024); } while (0)
#define PG8_LDB(dst, b, h) do { _Pragma("unroll") for (int n = 0; n < 2; ++n) _Pragma("unroll") for (int k = 0; k < 2; ++k) dst[n][k] = *(const PG8_LAS bf16x8*)(lds + PG8_SB(b, h) + boff + n * 2048 + k * 1024); } while (0)
#define PG8_MMA(ai, bj, At, Bt) do { __builtin_amdgcn_s_setprio(1); _Pragma("unroll") for (int m = 0; m < 4; ++m) _Pragma("unroll") for (int n = 0; n < 2; ++n) _Pragma("unroll") for (int k = 0; k < 2; ++k) \
        acc[ai][bj][m][n] = __builtin_amdgcn_mfma_f32_16x16x32_bf16(Bt[n][k], At[m][k], acc[ai][bj][m][n], 0, 0, 0); __builtin_amdgcn_s_setprio(0); } while (0)
#define PG8_WAIT_V(n) asm volatile("s_waitcnt vmcnt(" #n ")" ::: "memory")
#define PG8_WAIT_L(n) asm volatile("s_waitcnt lgkmcnt(" #n ")" ::: "memory")
#define PG8_BAR __builtin_amdgcn_s_barrier()
#define PG8_SCHED __builtin_amdgcn_sched_barrier(0)
    Unit cur, nxt; int ui = 0;
    if (!S.next(0, cur)) return;
    f32x4 acc[2][2][4][2];
#pragma unroll
    for (int a = 0; a < 2; ++a)
#pragma unroll
        for (int b = 0; b < 2; ++b)
#pragma unroll
            for (int m = 0; m < 4; ++m)
#pragma unroll
                for (int n = 0; n < 2; ++n) acc[a][b][m][n] = (f32x4){0.f, 0.f, 0.f, 0.f};
    bf16x8 At[4][2], B0[2][2], B1[2][2];
    const char* cA = (const char*)g.A + (size_t)cur.pm * tstep; const char* cB = (const char*)g.Bt + (size_t)cur.pn * tstep;
    S.a_ready(cur);
    if constexpr (SP2) {
        PG8_STAGE(PG8_SB(0, 0), cB, voffB); PG8_STAGE(PG8_SB(0, 1), cB + hstep, voffB); PG8_STAGE(PG8_SA(0, 0), cA, voffA); PG8_STAGE(PG8_SA(0, 1), cA + hstep, voffA);
        if (wr == 1) PG8_BAR;
        PG8_WAIT_V(2); PG8_BAR;
        PG8_STAGE(PG8_SB(1, 0), cB + kstep, voffB); PG8_STAGE(PG8_SA(1, 0), cA + kstep, voffA); PG8_STAGE(PG8_SB(1, 1), cB + hstep + kstep, voffB);
        PG8_WAIT_V(6); PG8_BAR;
    } else {
        PG8_STAGE(PG8_SB(0, 0), cB, voffB); PG8_STAGE(PG8_SA(0, 0), cA, voffA); PG8_STAGE(PG8_SB(0, 1), cB + hstep, voffB); PG8_STAGE(PG8_SA(0, 1), cA + hstep, voffA);
        if (wr == 1) PG8_BAR;
        PG8_WAIT_V(4); PG8_BAR;
        PG8_STAGE(PG8_SB(1, 0), cB + kstep, voffB); PG8_STAGE(PG8_SA(1, 0), cA + kstep, voffA); PG8_STAGE(PG8_SB(1, 1), cB + hstep + kstep, voffB);
        PG8_WAIT_V(6); PG8_BAR;
    }
    for (;;) {
        const bool has_next = S.next(ui + 1, nxt);
        const char* nA = has_next ? (const char*)g.A + (size_t)nxt.pm * tstep : cA; const char* nB = has_next ? (const char*)g.Bt + (size_t)nxt.pn * tstep : cB;
        for (int t = 0; t < nt; t += 2) {
            const bool last = (t == nt - 2);
            const char* a1 = cA + (size_t)(t + 1) * kstep;
            const char* a2 = last ? nA : cA + (size_t)(t + 2) * kstep; const char* b2 = last ? nB : cB + (size_t)(t + 2) * kstep;
            const char* a3 = a2 + kstep; const char* b3 = b2 + kstep;
            if (last && has_next) S.a_ready(nxt);
            if constexpr (SP2) {
            PG8_LDB(B0, 0, 0); PG8_LDB(B1, 0, 1); PG8_SCHED; PG8_LDA(At, 0, 0); PG8_STAGE(PG8_SA(1, 1), a1 + hstep, voffA);
            PG8_WAIT_V(8); PG8_WAIT_L(0); PG8_BAR; PG8_MMA(0, 0, At, B0); PG8_MMA(0, 1, At, B1); PG8_BAR; PG8_SCHED;
            PG8_LDA(At, 0, 1); PG8_STAGE(PG8_SB(0, 0), b2, voffB); PG8_STAGE(PG8_SB(0, 1), b2 + hstep, voffB); PG8_STAGE(PG8_SA(0, 0), a2, voffA);
            PG8_WAIT_V(8); PG8_WAIT_L(0); PG8_BAR; PG8_MMA(1, 0, At, B0); PG8_MMA(1, 1, At, B1); PG8_BAR; PG8_SCHED;
            PG8_LDB(B0, 1, 0); PG8_LDB(B1, 1, 1); PG8_SCHED; PG8_LDA(At, 1, 0); PG8_STAGE(PG8_SA(0, 1), a2 + hstep, voffA);
            PG8_WAIT_V(8); PG8_WAIT_L(0); PG8_BAR; PG8_MMA(0, 0, At, B0); PG8_MMA(0, 1, At, B1); PG8_BAR; PG8_SCHED;
            PG8_LDA(At, 1, 1); PG8_STAGE(PG8_SB(1, 0), b3, voffB); PG8_STAGE(PG8_SB(1, 1), b3 + hstep, voffB); PG8_STAGE(PG8_SA(1, 0), a3, voffA);
            PG8_WAIT_V(8); PG8_WAIT_L(0); PG8_BAR; PG8_MMA(1, 0, At, B0); PG8_MMA(1, 1, At, B1); PG8_BAR; PG8_SCHED;
            } else {
            PG8_LDB(B0, 0, 0); PG8_SCHED; PG8_LDA(At, 0, 0); PG8_STAGE(PG8_SA(1, 1), a1 + hstep, voffA);
            PG8_WAIT_L(8); PG8_BAR; PG8_WAIT_L(0); PG8_MMA(0, 0, At, B0); PG8_BAR; PG8_SCHED;
            PG8_LDB(B1, 0, 1); PG8_STAGE(PG8_SB(0, 0), b2, voffB);
            PG8_BAR; PG8_WAIT_L(0); PG8_MMA(0, 1, At, B1); PG8_BAR;
            PG8_LDA(At, 0, 1); PG8_STAGE(PG8_SA(0, 0), a2, voffA);
            PG8_BAR; PG8_WAIT_L(0); PG8_MMA(1, 0, At, B0); PG8_BAR; PG8_SCHED;
            PG8_STAGE(PG8_SB(0, 1), b2 + hstep, voffB);
            PG8_WAIT_V(6); PG8_BAR; PG8_MMA(1, 1, At, B1); PG8_BAR;
            PG8_LDB(B0, 1, 0); PG8_SCHED; PG8_LDA(At, 1, 0); PG8_STAGE(PG8_SA(0, 1), a2 + hstep, voffA);
            PG8_WAIT_L(8); PG8_BAR; PG8_WAIT_L(0); PG8_MMA(0, 0, At, B0); PG8_BAR; PG8_SCHED;
            PG8_LDB(B1, 1, 1); PG8_STAGE(PG8_SB(1, 0), b3, voffB);
            PG8_BAR; PG8_WAIT_L(0); PG8_MMA(0, 1, At, B1); PG8_BAR;
            PG8_LDA(At, 1, 1); PG8_STAGE(PG8_SA(1, 0), a3, voffA);
            PG8_BAR; PG8_WAIT_L(0); PG8_MMA(1, 0, At, B0); PG8_BAR; PG8_SCHED;
            PG8_STAGE(PG8_SB(1, 1), b3 + hstep, voffB);
            PG8_WAIT_V(6); PG8_BAR; PG8_MMA(1, 1, At, B1); PG8_BAR;
            }
        }
        if constexpr (ALIGN_EPI) { if (wr == 0) PG8_BAR; }
        if constexpr (!Epi::AFTER_DRAIN) { E(acc, cur, wr, wc, fr, fq); S.done(cur); }
        if (!has_next) break;
#pragma unroll
        for (int a = 0; a < 2; ++a)
#pragma unroll
            for (int b = 0; b < 2; ++b)
#pragma unroll
                for (int m = 0; m < 4; ++m)
#pragma unroll
                    for (int n = 0; n < 2; ++n) acc[a][b][m][n] = (f32x4){0.f, 0.f, 0.f, 0.f};
        cur = nxt; cA = nA; cB = nB; ++ui;
        if constexpr (ALIGN_EPI) { if (wr == 1) PG8_BAR; }
    }
    PG8_WAIT_V(0);
    if constexpr (!ALIGN_EPI) { if (wr == 0) PG8_BAR; }
    PG8_BAR;
    if constexpr (Epi::AFTER_DRAIN) { E.fused(acc, cur, wr, wc, fr, fq, lds, wid, lane); S.done(cur); }
#undef PG8_SA
#undef PG8_SB
#undef PG8_STAGE
#undef PG8_LDA
#undef PG8_LDB
#undef PG8_MMA
#undef PG8_WAIT_V
#undef PG8_WAIT_L
#undef PG8_BAR
#undef PG8_SCHED
}
}

#ifndef MK_N_LAUNCHES
#define MK_N_LAUNCHES 1
#endif
constexpr int N_PHASES = 11;
constexpr int DM = 2048, NBATCH = 4, SEQ = 2048, MP = NBATCH * SEQ, DB = 8, DS = 8, MS = DB * DS;
constexpr int NH = 8, HD = 128, DA = 1024, DC = 1024, DFF = 8192, DIN = 5120, NBUF = 2048;
constexpr float LN_EPS = 1e-5f;
constexpr float DN_ALPHA = 1.189207115002721f;
constexpr float SC2 = 0.08838834764831845f * 1.4426950408889634f;
constexpr float LOG2E = 1.4426950408889634f;

constexpr size_t O_YP = 0, O_YS = 16777216, O_KP = 16908288, O_VP = 25296896, O_CP = 33685504, O_KS = 33808384, O_VS = 50585600, O_CS = 67362816, O_END = 67608576;

constexpr size_t MiB = 1u << 20;
constexpr size_t WS_WIN = 2 * MiB, WS_WOUT = 22 * MiB, WS_WUP = 30 * MiB, WS_WDN = 62 * MiB;
constexpr size_t WS_T1 = 94 * MiB;
constexpr size_t WS_HB = 158 * MiB;
constexpr size_t WS_SMP = 190 * MiB;
constexpr size_t WS_XS = WS_SMP, WS_MIXS = WS_SMP + 256 * 1024, WS_HBS = WS_SMP + 512 * 1024, WS_T1S = WS_SMP + 1 * MiB, WS_PS = WS_SMP + 2 * MiB, WS_RS = WS_SMP + 4 * MiB;
constexpr size_t WS_XB = 196 * MiB;
constexpr size_t WS_QB = 228 * MiB, WS_KB = 244 * MiB, WS_VB = 260 * MiB;
constexpr size_t WS_U = 276 * MiB;
constexpr size_t WS_OP = 308 * MiB;
constexpr size_t WS_LSE = 356 * MiB;
constexpr size_t WS_R = 196 * MiB;
constexpr size_t WS_END = 357 * MiB;
static_assert(WS_VB - WS_KB == WS_KB - WS_QB, "q/k/v strides");

constexpr int LDS_BYTES = 147456;
constexpr int ATT_KOFF = 0, ATT_KSTR = 272, ATT_VOFF = 256 * 272, ATT_VSTR = 288;
static_assert(ATT_VOFF + 256 * ATT_VSTR <= LDS_BYTES, "attention LDS");

#define GAS __attribute__((address_space(1)))
#define LAS __attribute__((address_space(3)))
typedef unsigned short bf16;
typedef unsigned v4u __attribute__((ext_vector_type(4)));
typedef unsigned v2u __attribute__((ext_vector_type(2)));
typedef float f32x4 __attribute__((ext_vector_type(4)));
typedef float f32x2 __attribute__((ext_vector_type(2)));
typedef short bf16x8 __attribute__((ext_vector_type(8)));
typedef short s16x4 __attribute__((ext_vector_type(4)));
#define LDS_WAIT() asm volatile("s_waitcnt lgkmcnt(0)" ::: "memory")
using pg8::cvt_pk_bf16;

template <int CTRL> __device__ __forceinline__ float dpp_add(float v) { return v + __int_as_float(__builtin_amdgcn_update_dpp(0, __float_as_int(v), CTRL, 0xF, 0xF, true)); }
__device__ __forceinline__ float sum8(float v) { v = dpp_add<0xB1>(v); v = dpp_add<0x4E>(v); v = dpp_add<0x141>(v); return v; }
__device__ __forceinline__ float row16_sum(float v) { return dpp_add<0x140>(sum8(v)); }
__device__ __forceinline__ float rdlane(float v, int l) { return __int_as_float(__builtin_amdgcn_readlane(__float_as_int(v), l)); }
__device__ __forceinline__ float wave_sum(float v) { v = row16_sum(v); return (rdlane(v, 0) + rdlane(v, 16)) + (rdlane(v, 32) + rdlane(v, 48)); }
__device__ __forceinline__ float wave_max(float v) {
#pragma unroll
    for (int o = 1; o < 64; o <<= 1) v = fmaxf(v, __shfl_xor(v, o));
    return v;
}
__device__ __forceinline__ float fast_exp2(float x) { return __builtin_amdgcn_exp2f(x); }
__device__ __forceinline__ float sigmoidf_(float g) { return __builtin_amdgcn_rcpf(1.0f + fast_exp2(-g * LOG2E)); }
__device__ __forceinline__ float bf2f(unsigned short b) { return __uint_as_float(((unsigned)b) << 16); }

struct EpiG1 {
    static constexpr bool PERM = true, AFTER_DRAIN = false;
    bf16* QB; float* U; float* kout; float* convp;
    __device__ __forceinline__ void operator()(const f32x4 (&acc)[2][2][4][2], const pg8::Unit& u, int wr, int wc, int fr, int fq) const {
        const int row0 = u.pm * 256 + wr * 64 + fr;
        if (u.pn < 12) {
            const int t = u.pn >> 2; const int colt = (u.pn & 3) * 256 + wc * 32 + 8 * fq;
            bf16* B = QB + (size_t)t * ((WS_KB - WS_QB) / 2); float* O = kout + (size_t)(t == 2 ? 1 : 0) * (O_VP - O_KP);
#pragma unroll
            for (int ai = 0; ai < 2; ++ai)
#pragma unroll
                for (int m = 0; m < 4; ++m) { const size_t r = (size_t)(row0 + ai * 128 + m * 16);
#pragma unroll
                    for (int bj = 0; bj < 2; ++bj) { const f32x4 v0 = acc[ai][bj][m][0], v1 = acc[ai][bj][m][1]; const int c = colt + bj * 128;
                        v4u w; w.x = cvt_pk_bf16(v0[0], v0[1]); w.y = cvt_pk_bf16(v0[2], v0[3]); w.z = cvt_pk_bf16(v1[0], v1[1]); w.w = cvt_pk_bf16(v1[2], v1[3]);
                        *(v4u*)(B + r * 1024 + c) = w;
                        if (t != 0) { *(f32x4*)(O + r * 1024 + c) = v0; *(f32x4*)(O + r * 1024 + c + 4) = v1; } } }
        } else {
            const int j = u.pn - 12; const int colt = j * 128 + wc * 32 + 8 * fq;
#pragma unroll
            for (int ai = 0; ai < 2; ++ai)
#pragma unroll
                for (int m = 0; m < 4; ++m) { const int ri = row0 + ai * 128 + m * 16; const size_t r = (size_t)ri;
#pragma unroll
                    for (int n = 0; n < 2; ++n) { const f32x4 a = acc[ai][0][m][n], g = acc[ai][1][m][n]; f32x4 o;
#pragma unroll
                        for (int e = 0; e < 4; ++e) o[e] = a[e] * sigmoidf_(g[e]);
                        const int c = colt + 4 * n;
                        *(f32x4*)(U + r * 1024 + c) = o;
                        const int pos = ri & 2047;
                        if (pos >= 2018) *(f32x4*)(convp + ((size_t)((ri >> 11) * 30 + pos - 2018)) * 1024 + c) = o; } }
        }
    }
};
struct EpiRes {
    static constexpr bool PERM = false, AFTER_DRAIN = false;
    const float* base; float* out;
    __device__ __forceinline__ void operator()(const f32x4 (&acc)[2][2][4][2], const pg8::Unit& u, int wr, int wc, int fr, int fq) const {
        const int row0 = u.pm * 256 + wr * 64 + fr, col0 = u.pn * 256 + wc * 32 + 4 * fq;
#pragma unroll
        for (int ai = 0; ai < 2; ++ai)
#pragma unroll
            for (int m = 0; m < 4; ++m) { const size_t off = (size_t)(row0 + ai * 128 + m * 16) * DM + col0;
#pragma unroll
                for (int bj = 0; bj < 2; ++bj)
#pragma unroll
                    for (int n = 0; n < 2; ++n) { const f32x4 bs = *(const f32x4*)(base + off + bj * 128 + n * 16);
                        *(f32x4*)(out + off + bj * 128 + n * 16) = bs * DN_ALPHA + acc[ai][bj][m][n]; }
                asm volatile("" ::: "memory"); }
    }
};
struct EpiRelu2 {
    static constexpr bool PERM = true, AFTER_DRAIN = false;
    bf16* R;
    __device__ __forceinline__ void operator()(const f32x4 (&acc)[2][2][4][2], const pg8::Unit& u, int wr, int wc, int fr, int fq) const {
        const int row0 = u.pm * 256 + wr * 64 + fr, col0 = u.pn * 256 + wc * 32 + 8 * fq;
#pragma unroll
        for (int ai = 0; ai < 2; ++ai)
#pragma unroll
            for (int m = 0; m < 4; ++m) { bf16* rowp = R + (size_t)(row0 + ai * 128 + m * 16) * DFF + col0;
#pragma unroll
                for (int bj = 0; bj < 2; ++bj) { f32x4 v0 = acc[ai][bj][m][0], v1 = acc[ai][bj][m][1];
#pragma unroll
                    for (int e = 0; e < 4; ++e) { const float a = fmaxf(v0[e], 0.f), b = fmaxf(v1[e], 0.f); v0[e] = a * a; v1[e] = b * b; }
                    v4u w; w.x = cvt_pk_bf16(v0[0], v0[1]); w.y = cvt_pk_bf16(v0[2], v0[3]); w.z = cvt_pk_bf16(v1[0], v1[1]); w.w = cvt_pk_bf16(v1[2], v1[3]);
                    *(v4u*)(rowp + bj * 128) = w; } }
    }
};

template <class E>
__device__ __forceinline__ void skinny_phase(LAS unsigned char* lds, const bf16* A, const bf16* Bt, int N, int K, int first, int stride, const E& e) {
    const int tid = threadIdx.x, lane = tid & 63, wave = __builtin_amdgcn_readfirstlane(tid >> 6), fr = lane & 15, fq = lane >> 4;
    const int ksl = K >> 3, nks = ksl >> 5;
    LAS f32x4* red = (LAS f32x4*)lds;
    for (int task = first; task < (N >> 4); task += stride) {
        f32x4 acc[4];
#pragma unroll
        for (int m = 0; m < 4; ++m) acc[m] = (f32x4){0.f, 0.f, 0.f, 0.f};
        const bf16* bp = Bt + (size_t)(task * 16 + fr) * K + wave * ksl + fq * 8;
        const bf16* ap = A + (size_t)fr * K + wave * ksl + fq * 8;
#pragma unroll 4
        for (int ks = 0; ks < nks; ++ks) {
            const bf16x8 b = *(const bf16x8*)(bp + ks * 32);
#pragma unroll
            for (int m = 0; m < 4; ++m) { const bf16x8 a = *(const bf16x8*)(ap + (size_t)(m * 16) * K + ks * 32);
                acc[m] = __builtin_amdgcn_mfma_f32_16x16x32_bf16(a, b, acc[m], 0, 0, 0); }
        }
#pragma unroll
        for (int m = 0; m < 4; ++m) red[(wave * 4 + m) * 64 + lane] = acc[m];
        __syncthreads();
        {
            const int row = tid >> 3, cp = tid & 7; const int m = row >> 4, q = (row & 15) >> 2, j = row & 3;
            float v0 = 0.f, v1 = 0.f;
            const LAS float* rf = (const LAS float*)lds;
#pragma unroll
            for (int w = 0; w < 8; ++w) { v0 += rf[(((w * 4 + m) * 64) + q * 16 + 2 * cp) * 4 + j]; v1 += rf[(((w * 4 + m) * 64) + q * 16 + 2 * cp + 1) * 4 + j]; }
            e(row, task * 16 + 2 * cp, v0, v1);
        }
        __syncthreads();
    }
}
struct SkStore { float* out; int ld; __device__ __forceinline__ void operator()(int r, int c, float v0, float v1) const { *(f32x2*)(out + (size_t)r * ld + c) = (f32x2){v0, v1}; } };
struct SkRes { const float* base; float* out; __device__ __forceinline__ void operator()(int r, int c, float v0, float v1) const { const f32x2 b = *(const f32x2*)(base + (size_t)r * DM + c); *(f32x2*)(out + (size_t)r * DM + c) = (f32x2){b.x * DN_ALPHA + v0, b.y * DN_ALPHA + v1}; } };
struct SkRelu2 { bf16* R; __device__ __forceinline__ void operator()(int r, int c, float v0, float v1) const { const float a = fmaxf(v0, 0.f), b = fmaxf(v1, 0.f); *(unsigned*)(R + (size_t)r * DFF + c) = cvt_pk_bf16(a * a, b * b); } };

__device__ __forceinline__ void transpose_item(const float* W, int K, int N, bf16* WT, int dst_n0, LAS float* scr, int k0, int n0, int lane) {
#pragma unroll 8
    for (int i = 0; i < 32; ++i) { const int kk = 2 * i + (lane >> 5); scr[kk * 33 + (lane & 31)] = W[(size_t)(k0 + kk) * N + n0 + (lane & 31)]; }
    LDS_WAIT(); asm volatile("" ::: "memory");
    const int c = lane & 7;
#pragma unroll
    for (int j = 0; j < 4; ++j) { const int n = (lane >> 3) + 8 * j; const LAS float* s = scr + (8 * c) * 33 + n;
        v4u o; o.x = cvt_pk_bf16(s[0 * 33], s[1 * 33]); o.y = cvt_pk_bf16(s[2 * 33], s[3 * 33]); o.z = cvt_pk_bf16(s[4 * 33], s[5 * 33]); o.w = cvt_pk_bf16(s[6 * 33], s[7 * 33]);
        *(v4u*)(WT + (size_t)(dst_n0 + n) * K + k0 + 8 * c) = o; }
    LDS_WAIT(); asm volatile("" ::: "memory");
}
__device__ __forceinline__ int win_dst(int n0) {
    if (n0 < 3072) return n0;
    if (n0 < 4096) { const int c = n0 - 3072; return 3072 + (c >> 7) * 256 + (c & 127); }
    const int c = n0 - 4096; return 3072 + (c >> 7) * 256 + 128 + (c & 127);
}

template <bool WB>
__device__ __forceinline__ void ln_row(const float* in, float* out, bf16* outb, const float* g, const float* b, int lane) {
    const f32x4* xr = (const f32x4*)in + lane; f32x4 v[8]; float s = 0.f;
#pragma unroll
    for (int j = 0; j < 8; ++j) { v[j] = xr[64 * j]; s += (v[j].x + v[j].y) + (v[j].z + v[j].w); }
    const float mean = wave_sum(s) * (1.f / DM); float s2 = 0.f;
#pragma unroll
    for (int j = 0; j < 8; ++j) { v[j] = v[j] - mean; s2 += (v[j].x * v[j].x + v[j].y * v[j].y) + (v[j].z * v[j].z + v[j].w * v[j].w); }
    const float rstd = 1.f / sqrtf(wave_sum(s2) * (1.f / DM) + LN_EPS);
#pragma unroll
    for (int j = 0; j < 8; ++j) { const f32x4 gg = ((const f32x4*)g)[64 * j + lane], bb = ((const f32x4*)b)[64 * j + lane];
        const f32x4 o = v[j] * rstd * gg + bb; ((f32x4*)out)[64 * j + lane] = o;
        if (WB) { v2u w; w.x = cvt_pk_bf16(o.x, o.y); w.y = cvt_pk_bf16(o.z, o.w); ((v2u*)outb)[64 * j + lane] = w; } }
}

template <class LD>
__device__ __forceinline__ void conv_item(const LD& ld, int nch, const float* w_dw, const float* b_dw, const float* lg, const float* lb, bf16* mix0, LAS float* red, int tid, int lane, int wave) {
    const int c = tid * 2;
    f32x2 w[31];
#pragma unroll
    for (int j = 0; j < 31; ++j) w[j] = *(const f32x2*)(w_dw + j * 1024 + c);
    const f32x2 bias = *(const f32x2*)(b_dw + c), gg = *(const f32x2*)(lg + c), bb = *(const f32x2*)(lb + c);
    f32x2 win[38];
#pragma unroll
    for (int i = 0; i < 30; ++i) win[i] = ld(i, c);
#pragma nounroll
    for (int ch = 0; ch < nch; ++ch) {
#pragma unroll
        for (int k = 0; k < 8; ++k) win[30 + k] = ld(30 + 8 * ch + k, c);
        f32x2 acc[8];
#pragma unroll
        for (int tt = 0; tt < 8; ++tt) { f32x2 a = bias;
#pragma unroll
            for (int j = 0; j < 31; ++j) a += win[tt + j] * w[j];
            acc[tt] = a; }
        LAS float* rb = red + (ch & 1) * 128;
#pragma unroll
        for (int tt = 0; tt < 8; ++tt) { const float s1 = wave_sum(acc[tt].x + acc[tt].y), s2 = wave_sum(acc[tt].x * acc[tt].x + acc[tt].y * acc[tt].y);
            if (lane == 0) *(LAS f32x2*)(rb + (tt * 8 + wave) * 2) = (f32x2){s1, s2}; }
        __syncthreads();
        const f32x2 pr = *(const LAS f32x2*)(rb + lane * 2);
        const float t1 = sum8(pr.x), t2 = sum8(pr.y);
#pragma unroll
        for (int tt = 0; tt < 8; ++tt) { const float s1 = rdlane(t1, tt * 8), s2 = rdlane(t2, tt * 8);
            const float mean = s1 * (1.f / 1024.f), var = s2 * (1.f / 1024.f) - mean * mean, rstd = 1.f / sqrtf(fmaxf(var, 0.f) + LN_EPS);
            f32x2 y = (acc[tt] - mean) * rstd * gg + bb;
            y.x = y.x * sigmoidf_(y.x); y.y = y.y * sigmoidf_(y.y);
            *(unsigned*)(mix0 + (size_t)(ch * 8 + tt) * DM + c) = cvt_pk_bf16(y.x, y.y); }
#pragma unroll
        for (int i = 0; i < 30; ++i) win[i] = win[i + 8];
    }
    __syncthreads();
}
struct LdPrompt { const float* U; int b, t0;
    __device__ __forceinline__ f32x2 operator()(int i, int c) const { const int pos = t0 - 30 + i; if (pos < 0) return (f32x2){0.f, 0.f}; return *(const f32x2*)(U + (size_t)(b * 2048 + pos) * 1024 + c); } };
struct LdSample { const float* state; const float* PS; float* convs; int n;
    __device__ __forceinline__ f32x2 operator()(int i, int c) const {
        if (i < 30) return *(const f32x2*)(state + (size_t)(n * 30 + i) * 1024 + c);
        const float* pr = PS + (size_t)(n * 8 + i - 30) * DIN + 3072 + (c >> 7) * 256 + (c & 127);
        const f32x2 a = *(const f32x2*)pr, g = *(const f32x2*)(pr + 128);
        const f32x2 u = (f32x2){a.x * sigmoidf_(g.x), a.y * sigmoidf_(g.y)};
        *(f32x2*)(convs + (size_t)(n * 30 + i - 8) * 1024 + c) = u;
        return u; } };

__device__ __forceinline__ void attn_item(LAS unsigned char* lds, const bf16* QB, const bf16* KB, const bf16* VB, bf16* OP, float* LSE, int it, int tid, int lane, int wave) {
    const int bh = it / 48, rem = it - bh * 48, p = rem >> 4, idx = rem & 15;
    const int b = bh >> 3, h = bh & 7, dil = 1 << (2 * p);
    const int cls = p == 0 ? 0 : (p == 1 ? (idx & 3) : idx), blk = p == 0 ? idx : (p == 1 ? (idx >> 2) : 0);
    const int kb0 = blk == 0 ? 8 : 0;
    const int fr = lane & 15, fq = lane >> 4;
    {
        v4u kr[8], vr[8]; const int row0 = tid >> 4, ch = tid & 15;
#pragma unroll
        for (int i = 0; i < 8; ++i) if (i >= (kb0 >> 1)) { const int row = row0 + 32 * i; const size_t tok = (size_t)(b * 2048 + (blk * 128 - 128 + row) * dil + cls);
            kr[i] = *(const v4u*)(KB + tok * 1024 + h * 128 + ch * 8); vr[i] = *(const v4u*)(VB + tok * 1024 + h * 128 + ch * 8); }
#pragma unroll
        for (int i = 0; i < 8; ++i) if (i >= (kb0 >> 1)) { const int row = row0 + 32 * i;
            *(LAS v4u*)(lds + ATT_KOFF + row * ATT_KSTR + ch * 16) = kr[i]; *(LAS v4u*)(lds + ATT_VOFF + row * ATT_VSTR + ch * 16) = vr[i]; }
    }
    const int qi = wave * 16 + fr;
    const size_t tq = (size_t)(b * 2048 + (blk * 128 + qi) * dil + cls);
    bf16x8 qf[4];
#pragma unroll
    for (int ks = 0; ks < 4; ++ks) qf[ks] = *(const bf16x8*)(QB + tq * 1024 + h * 128 + ks * 32 + fq * 8);
    __syncthreads();
    f32x4 S[9];
#pragma unroll
    for (int kk = 0; kk < 9; ++kk) { const int kb = wave + kk; f32x4 a = (f32x4){0.f, 0.f, 0.f, 0.f};
#pragma unroll
        for (int ks = 0; ks < 4; ++ks) { const bf16x8 kf = *(const LAS bf16x8*)(lds + ATT_KOFF + (kb * 16 + fr) * ATT_KSTR + (ks * 32 + fq * 8) * 2);
            a = __builtin_amdgcn_mfma_f32_16x16x32_bf16(kf, qf[ks], a, 0, 0, 0); }
        S[kk] = a; }
    float mx = -INFINITY;
#pragma unroll
    for (int kk = 0; kk < 9; ++kk) { const int kb = wave + kk;
#pragma unroll
        for (int j = 0; j < 4; ++j) { const int kidx = kb * 16 + fq * 4 + j; const bool valid = (kidx >= qi) && (kidx <= qi + 128) && (kb >= kb0);
            const float s = valid ? S[kk][j] * SC2 : -INFINITY; S[kk][j] = s; mx = fmaxf(mx, s); } }
    mx = fmaxf(mx, __shfl_xor(mx, 16)); mx = fmaxf(mx, __shfl_xor(mx, 32));
    float l = 0.f;
#pragma unroll
    for (int kk = 0; kk < 9; ++kk)
#pragma unroll
        for (int j = 0; j < 4; ++j) { const float e = fast_exp2(S[kk][j] - mx); S[kk][j] = e; l += e; }
    l += __shfl_xor(l, 16); l += __shfl_xor(l, 32);
    bf16x8 pf[5];
#pragma unroll
    for (int s = 0; s < 5; ++s) { v4u w; w.x = cvt_pk_bf16(S[2 * s][0], S[2 * s][1]); w.y = cvt_pk_bf16(S[2 * s][2], S[2 * s][3]);
        if (s < 4) { w.z = cvt_pk_bf16(S[2 * s + 1][0], S[2 * s + 1][1]); w.w = cvt_pk_bf16(S[2 * s + 1][2], S[2 * s + 1][3]); } else { w.z = 0u; w.w = 0u; }
        pf[s] = __builtin_bit_cast(bf16x8, w); }
    const float rl = 1.0f / l;
    bf16* orow = OP + (size_t)p * ((size_t)MP * 1024) + tq * 1024 + h * 128;
#pragma unroll
    for (int db = 0; db < 8; ++db) { f32x4 o = (f32x4){0.f, 0.f, 0.f, 0.f};
#pragma unroll
        for (int s = 0; s < 5; ++s) { int kbA = wave + 2 * s, kbB = wave + 2 * s + 1; kbA = kbA < kb0 ? kb0 : kbA; kbB = kbB < kb0 ? kb0 : (kbB > 15 ? 15 : kbB);
            const s16x4 r1 = __builtin_bit_cast(s16x4, __builtin_amdgcn_ds_read_tr16_b64_v4i16((LAS s16x4*)(lds + ATT_VOFF + (kbA * 16 + fq * 4 + (fr >> 2)) * ATT_VSTR + (db * 16 + 4 * (fr & 3)) * 2)));
            const s16x4 r2 = __builtin_bit_cast(s16x4, __builtin_amdgcn_ds_read_tr16_b64_v4i16((LAS s16x4*)(lds + ATT_VOFF + (kbB * 16 + fq * 4 + (fr >> 2)) * ATT_VSTR + (db * 16 + 4 * (fr & 3)) * 2)));
            const bf16x8 vf = (bf16x8){r1[0], r1[1], r1[2], r1[3], r2[0], r2[1], r2[2], r2[3]};
            o = __builtin_amdgcn_mfma_f32_16x16x32_bf16(vf, pf[s], o, 0, 0, 0); }
        v2u w; w.x = cvt_pk_bf16(o[0] * rl, o[1] * rl); w.y = cvt_pk_bf16(o[2] * rl, o[3] * rl);
        *(v2u*)(orow + db * 16 + fq * 4) = w; }
    if (fq == 0) LSE[(size_t)p * (MP * 8) + tq * 8 + h] = mx + __builtin_amdgcn_logf(l);
    __syncthreads();
}

__device__ __forceinline__ void sattn_block(LAS float* sm, const float* PS, const float* ck, const float* cv, bf16* MIXS, float* kws, float* vws, int bi, int tid, int lane, int wave) {
    const int n = bi >> 5, t = (bi >> 2) & 7, hp = bi & 3;
    const float* prow = PS + (size_t)(n * 8 + t) * DIN;
    if (wave < 6) {
        const int h = hp * 2 + (wave >= 3 ? 1 : 0), p = wave >= 3 ? wave - 3 : wave;
        const int grp = lane >> 4, sub = lane & 15;
        const f32x4 q0 = *(const f32x4*)(prow + h * 128 + sub * 8), q1 = *(const f32x4*)(prow + h * 128 + sub * 8 + 4);
        LAS float* ssc = sm + 8 * 136 + wave * 132;
        float m = -INFINITY;
#pragma nounroll
        for (int bt = 0; bt < 3; ++bt) { f32x4 k0[11], k1[11];
#pragma unroll
            for (int i = 0; i < 11; ++i) { const int j = (bt * 11 + i) * 4 + grp, jc = j > 128 ? 128 : j; const int e = 2048 + t - (jc << (2 * p));
                const float* kr = (e < 2048) ? ck + ((size_t)(n * 2048 + e) * 8 + h) * 128 : PS + (size_t)(n * 8 + e - 2048) * DIN + 1024 + h * 128;
                k0[i] = *(const f32x4*)(kr + sub * 8); k1[i] = *(const f32x4*)(kr + sub * 8 + 4); }
#pragma unroll
            for (int i = 0; i < 11; ++i) { const int j = (bt * 11 + i) * 4 + grp;
                float d = (q0.x * k0[i].x + q0.y * k0[i].y) + (q0.z * k0[i].z + q0.w * k0[i].w) + (q1.x * k1[i].x + q1.y * k1[i].y) + (q1.z * k1[i].z + q1.w * k1[i].w);
                d = row16_sum(d); const float sv = j <= 128 ? d * SC2 : -INFINITY; m = fmaxf(m, sv);
                if (sub == 0) ssc[(bt * 11 + i) * 4 + grp] = sv; } }
        m = fmaxf(m, __shfl_xor(m, 16)); m = fmaxf(m, __shfl_xor(m, 32));
        LDS_WAIT(); asm volatile("" ::: "memory");
        float l = 0.f; f32x4 o0 = (f32x4){0.f, 0.f, 0.f, 0.f}, o1 = o0;
#pragma nounroll
        for (int bt = 0; bt < 3; ++bt) { f32x4 v0[11], v1[11];
#pragma unroll
            for (int i = 0; i < 11; ++i) { const int j = (bt * 11 + i) * 4 + grp, jc = j > 128 ? 128 : j; const int e = 2048 + t - (jc << (2 * p));
                const float* vr = (e < 2048) ? cv + ((size_t)(n * 2048 + e) * 8 + h) * 128 : PS + (size_t)(n * 8 + e - 2048) * DIN + 2048 + h * 128;
                v0[i] = *(const f32x4*)(vr + sub * 8); v1[i] = *(const f32x4*)(vr + sub * 8 + 4); }
#pragma unroll
            for (int i = 0; i < 11; ++i) { const float pw = fast_exp2(ssc[(bt * 11 + i) * 4 + grp] - m); l += pw; o0 += v0[i] * pw; o1 += v1[i] * pw; } }
        l += __shfl_xor(l, 16); l += __shfl_xor(l, 32);
#pragma unroll
        for (int e = 0; e < 4; ++e) { o0[e] += __shfl_xor(o0[e], 16); o0[e] += __shfl_xor(o0[e], 32); o1[e] += __shfl_xor(o1[e], 16); o1[e] += __shfl_xor(o1[e], 32); }
        LAS float* w = sm + wave * 136;
        if (lane == 0) { w[0] = m; w[1] = l; }
        if (grp == 0) { *(LAS f32x4*)(w + 8 + sub * 8) = o0; *(LAS f32x4*)(w + 8 + sub * 8 + 4) = o1; }
    }
    __syncthreads();
    if (tid < 256) { const int ii = tid >> 7, d = tid & 127, h = hp * 2 + ii; const LAS float* w = sm + ii * 3 * 136;
        const float m0 = w[0], m1 = w[136], m2 = w[272], M = fmaxf(m0, fmaxf(m1, m2));
        const float e0 = fast_exp2(m0 - M), e1 = fast_exp2(m1 - M), e2 = fast_exp2(m2 - M);
        const float L = w[1] * e0 + w[137] * e1 + w[273] * e2;
        const float o = (w[8 + d] * e0 + w[136 + 8 + d] * e1 + w[272 + 8 + d] * e2) / L;
        MIXS[(size_t)(n * 8 + t) * DM + h * 128 + d] = (bf16)(cvt_pk_bf16(o, 0.f) & 0xffffu);
        const size_t orow = ((size_t)(n * 2048 + 2040 + t) * 8 + h) * 128 + d;
        kws[orow] = prow[1024 + h * 128 + d]; vws[orow] = prow[2048 + h * 128 + d]; }
    __syncthreads();
}

__device__ __forceinline__ void cache_copy(const float* cache_k, const float* cache_v, const float* state_conv, float* out, int idx, int nparts, int tid) {
    const f32x4* sk = (const f32x4*)cache_k; const f32x4* sv = (const f32x4*)cache_v; f32x4* dk = (f32x4*)(out + O_KS); f32x4* dv = (f32x4*)(out + O_VS);
    constexpr int TOT = 8 * 522240;
    const int per = (TOT + nparts - 1) / nparts, i0 = idx * per, i1 = (i0 + per) < TOT ? (i0 + per) : TOT;
    for (int base = i0; base < i1; base += 512 * 16) {
        f32x4 a[16], b[16];
#pragma unroll
        for (int u = 0; u < 16; ++u) { int i = base + u * 512 + tid; i = i < i1 ? i : i1 - 1; const int n = i / 522240, r = i - n * 522240; const size_t d = (size_t)n * 524288 + r;
            a[u] = __builtin_nontemporal_load(sk + d + 2048); b[u] = __builtin_nontemporal_load(sv + d + 2048); }
#pragma unroll
        for (int u = 0; u < 16; ++u) { int i = base + u * 512 + tid; i = i < i1 ? i : i1 - 1; const int n = i / 522240, r = i - n * 522240; const size_t d = (size_t)n * 524288 + r;
            __builtin_nontemporal_store(a[u], dk + d); __builtin_nontemporal_store(b[u], dv + d); }
    }
    const f32x4* ss = (const f32x4*)state_conv; f32x4* dc = (f32x4*)(out + O_CS);
    for (int i = idx * 512 + tid; i < 8 * 5632; i += nparts * 512) { const int n = i / 5632, r = i - n * 5632; dc[(size_t)n * 7680 + r] = ss[(size_t)n * 7680 + 2048 + r]; }
}

#define XB_TMO      128
#define XB_XCNT(j)  (256  + 64 * (j))
#define XB_XSUB(j)  (1280 + 64 * (j))
#define XB_XGEN(j)  (2304 + 64 * (j))
#define XB_TOP      3328
#define XB_TOPGEN   3392
#define XCD_BAR_WORDS 3456
#define XB_SPIN_CAP (1u << 18)

__device__ __forceinline__ unsigned xb_ld(unsigned* p)              { return __hip_atomic_load(p, __ATOMIC_RELAXED, __HIP_MEMORY_SCOPE_AGENT); }
__device__ __forceinline__ unsigned xb_add(unsigned* p, unsigned v) { return __hip_atomic_fetch_add(p, v, __ATOMIC_RELAXED, __HIP_MEMORY_SCOPE_AGENT); }
__device__ __forceinline__ unsigned xb_xcc_id() { return (unsigned)__builtin_amdgcn_s_getreg((3 << 11) | 20) & 0xFu; }
#define XB_SPIN(cond, bar) do { unsigned _sp = 0; while (cond) { __builtin_amdgcn_s_sleep(1); \
    if ((++_sp & 255u) == 0u) { if (xb_ld(&(bar)[XB_TMO])) break; if (_sp > XB_SPIN_CAP) { atomicAdd(&(bar)[XB_TMO], 1u); break; } } } } while (0)

struct XcdBarrier {
    unsigned* bar; unsigned x;
    volatile LAS unsigned* st;
};

__device__ __forceinline__ XcdBarrier xcd_barrier_post(unsigned* bar, volatile LAS unsigned* st) {
    XcdBarrier b; b.bar = bar; b.x = xb_xcc_id(); b.st = st;
    if (threadIdx.x == 0) (void)xb_add(&bar[XB_XCNT(b.x)], 1u);
    return b;
}
__device__ __forceinline__ void xcd_barrier_complete(unsigned* bar, unsigned x, unsigned& nloc, unsigned& nx) {
    const unsigned G = gridDim.x * gridDim.y * gridDim.z;
    unsigned sum, cnt, mine, sp = 0u;
    for (;;) {
        sum = 0u; cnt = 0u; mine = 0u;
#pragma unroll
        for (unsigned j = 0; j < 16; ++j) { const unsigned c = xb_ld(&bar[XB_XCNT(j)]); sum += c; cnt += (c > 0u) ? 1u : 0u; mine = (j == x) ? c : mine; }
        if (sum == G) break;
        __builtin_amdgcn_s_sleep(1);
        if ((++sp & 255u) == 0u) { if (xb_ld(&bar[XB_TMO])) break; if (sp > XB_SPIN_CAP) { atomicAdd(&bar[XB_TMO], 1u); break; } }
    }
    nloc = mine > 0u ? mine : 1u; nx = cnt > 0u ? cnt : 1u;
}

__device__ __forceinline__ void xcd_barrier(const XcdBarrier& b) {
    asm volatile("s_waitcnt vmcnt(0)" ::: "memory");
    __syncthreads();
    if (threadIdx.x == 0) {
        unsigned* bar = b.bar;
        __builtin_amdgcn_s_waitcnt(0);
        unsigned nloc = b.st[0], nx = b.st[1];
        if (nloc == 0u) { xcd_barrier_complete(bar, b.x, nloc, nx); b.st[0] = nloc; b.st[1] = nx; }
        const unsigned old = xb_add(&bar[XB_XSUB(b.x)], 1u);
        const unsigned gen = old / nloc;
        if (old + 1u == (gen + 1u) * nloc) {
            __builtin_amdgcn_fence(__ATOMIC_RELEASE, "agent");
            asm volatile("s_waitcnt vmcnt(0)" ::: "memory");
            const unsigned og = xb_add(&bar[XB_TOP], 1u);
            const unsigned tg = og / nx;
            if (og + 1u == (tg + 1u) * nx) xb_add(&bar[XB_TOPGEN], 1u);
            else XB_SPIN(xb_ld(&bar[XB_TOPGEN]) == tg, bar);
            __builtin_amdgcn_fence(__ATOMIC_ACQUIRE, "agent");
            xb_add(&bar[XB_XGEN(b.x)], 1u);
            asm volatile("s_waitcnt vmcnt(0)" ::: "memory");
        } else {
            XB_SPIN(xb_ld(&bar[XB_XGEN(b.x)]) == gen, bar);
            __builtin_amdgcn_fence(__ATOMIC_ACQUIRE, "agent");
            asm volatile("s_waitcnt vmcnt(0)" ::: "memory");
        }
    }
    __syncthreads();
}

struct Args { const float* in[17]; float* out; unsigned char* ws; int ph_lo, ph_hi; };
__global__ void __launch_bounds__(512, 2) fwd_kernel(Args args) {
    extern __shared__ __attribute__((aligned(16))) unsigned char lds_raw[];
    LAS unsigned char* lds = (LAS unsigned char*)lds_raw;
    const int tid = threadIdx.x, lane = tid & 63, wave = __builtin_amdgcn_readfirstlane(tid >> 6);
    const int G = gridDim.x, bx = blockIdx.x;
    const int vb = (G % 8 == 0) ? (bx % 8) * (G / 8) + bx / 8 : bx;
    const int gtid = vb * 512 + tid, NT = G * 512;
    const int gw = vb * 8 + wave, NGW = G * 8;
    cg::grid_group grid = cg::this_grid();
    volatile LAS unsigned* MISC = (volatile LAS unsigned*)(lds + LDS_BYTES - 64);
    if (tid < 16) MISC[tid] = 0u;
    __syncthreads();
    XcdBarrier bar = xcd_barrier_post((unsigned*)(args.ws) + 4096, MISC + 8);
    if (args.ph_lo > args.ph_hi) grid.sync();
    const int lo = args.ph_lo, hi = args.ph_hi;
#ifndef REP_MASK
#define REP_MASK 0
#endif
#ifndef EXTRA_SYNCS
#define EXTRA_SYNCS 0
#endif
#define REPS(k) _Pragma("nounroll") for (int rep_ = 0; rep_ < 1 + ((REP_MASK >> (k)) & 1); ++rep_)
#ifndef PH_MASK
#define PH_MASK 0x7FF
#endif
#define IN(k) (((PH_MASK >> (k)) & 1) && lo <= (k) && (k) < hi)
#define SEAM(k) do { if (IN(k) && IN((k) + 1)) xcd_barrier(bar); } while (0)
    unsigned char* ws = args.ws; float* out = args.out;
    const float* x_prompt = args.in[0]; const float* x_sample = args.in[1]; const float* cache_k = args.in[2]; const float* cache_v = args.in[3]; const float* state_conv = args.in[4];
    const float* w_in = args.in[5]; const float* w_dw = args.in[6]; const float* b_dw = args.in[7]; const float* lncg = args.in[8]; const float* lncb = args.in[9];
    const float* w_out = args.in[10]; const float* ln1g = args.in[11]; const float* ln1b = args.in[12]; const float* w_up = args.in[13]; const float* w_down = args.in[14];
    const float* ln2g = args.in[15]; const float* ln2b = args.in[16];
    bf16* WIN = (bf16*)(ws + WS_WIN); bf16* WOUT = (bf16*)(ws + WS_WOUT); bf16* WUP = (bf16*)(ws + WS_WUP); bf16* WDN = (bf16*)(ws + WS_WDN);
    float* T1 = (float*)(ws + WS_T1); bf16* HB = (bf16*)(ws + WS_HB);
    bf16* XS = (bf16*)(ws + WS_XS); bf16* MIXS = (bf16*)(ws + WS_MIXS); bf16* HBS = (bf16*)(ws + WS_HBS); float* T1S = (float*)(ws + WS_T1S); float* PS = (float*)(ws + WS_PS); bf16* RS = (bf16*)(ws + WS_RS);
    bf16* XB = (bf16*)(ws + WS_XB); bf16* MIXED = (bf16*)(ws + WS_XB); bf16* QB = (bf16*)(ws + WS_QB); bf16* KB = (bf16*)(ws + WS_KB); bf16* VB = (bf16*)(ws + WS_VB);
    float* U = (float*)(ws + WS_U); bf16* OP = (bf16*)(ws + WS_OP); float* LSE = (float*)(ws + WS_LSE); bf16* R = (bf16*)(ws + WS_R);

    if (IN(0)) {
        LAS float* scr = (LAS float*)(lds + wave * 8448);
        constexpr int I_IN = 32 * 160, I_OUT = 32 * 64, I_UP = 32 * 256, I_DN = 128 * 64;
        for (int it = gw; it < I_IN + I_OUT + I_UP + I_DN; it += NGW) {
            int r = it;
            if (r < I_IN) { const int kb = r / 160, nb = r % 160; transpose_item(w_in, DM, DIN, WIN, win_dst(32 * nb), scr, 64 * kb, 32 * nb, lane); continue; } r -= I_IN;
            if (r < I_OUT) { const int kb = r / 64, nb = r % 64; transpose_item(w_out, DM, DM, WOUT, 32 * nb, scr, 64 * kb, 32 * nb, lane); continue; } r -= I_OUT;
            if (r < I_UP) { const int kb = r / 256, nb = r % 256; transpose_item(w_up, DM, DFF, WUP, 32 * nb, scr, 64 * kb, 32 * nb, lane); continue; } r -= I_UP;
            { const int kb = r / 64, nb = r % 64; transpose_item(w_down, DFF, DM, WDN, 32 * nb, scr, 64 * kb, 32 * nb, lane); }
        }
        for (int i = gtid; i < MP * DM / 8; i += NT) { const f32x4 a = ((const f32x4*)x_prompt)[2 * i], b = ((const f32x4*)x_prompt)[2 * i + 1];
            v4u o; o.x = cvt_pk_bf16(a.x, a.y); o.y = cvt_pk_bf16(a.z, a.w); o.z = cvt_pk_bf16(b.x, b.y); o.w = cvt_pk_bf16(b.z, b.w); ((v4u*)XB)[i] = o; }
        for (int i = gtid; i < MS * DM / 8; i += NT) { const f32x4 a = ((const f32x4*)x_sample)[2 * i], b = ((const f32x4*)x_sample)[2 * i + 1];
            v4u o; o.x = cvt_pk_bf16(a.x, a.y); o.y = cvt_pk_bf16(a.z, a.w); o.z = cvt_pk_bf16(b.x, b.y); o.w = cvt_pk_bf16(b.z, b.w); ((v4u*)XS)[i] = o; }
        if (G != 256) cache_copy(cache_k, cache_v, state_conv, out, vb, G, tid);
    }
    SEAM(0);
    for (int es_ = 0; es_ < EXTRA_SYNCS; ++es_) xcd_barrier(bar);
    if (IN(1)) {
        pg8::Gemm g{XB, WIN, MP, DIN, DM}; pg8::StaticOrder S; S.init(MP, DIN, G, bx);
        EpiG1 E{QB, U, out + O_KP, out + O_CP};
        pg8::gemm_phase<EpiG1, pg8::StaticOrder, true, true>(lds, g, S, E);
        skinny_phase(lds, XS, WIN, DIN, DM, (G == 256) ? (bx >= 128 ? bx - 128 : (1 << 30)) : vb, (G == 256) ? 128 : G, SkStore{PS, DIN});
        if (G == 256 && bx >= 128) cache_copy(cache_k, cache_v, state_conv, out, bx - 128, 128, tid);
    }
    SEAM(1);
    if (IN(2)) {
        if (G == 256) {
            for (int i = 0; i < 6; ++i) attn_item(lds, QB, KB, VB, OP, LSE, (vb >> 3) * 48 + (vb & 7) + 8 * i, tid, lane, wave);
        } else {
            for (int it = bx; it < 1536; it += G) attn_item(lds, QB, KB, VB, OP, LSE, it, tid, lane, wave);
        }
    }
    if (IN(3)) {
        for (int it = bx; it < 264; it += G) {
            if (it < 256) { const int b = it >> 6, t0 = (it & 63) * 32;
                conv_item(LdPrompt{U, b, t0}, 4, w_dw, b_dw, lncg, lncb, MIXED + (size_t)(b * 2048 + t0) * DM + 1024, (LAS float*)lds, tid, lane, wave); }
            else { const int n = it - 256;
                conv_item(LdSample{state_conv, PS, out + O_CS, n}, 1, w_dw, b_dw, lncg, lncb, MIXS + (size_t)(n * 8) * DM + 1024, (LAS float*)lds, tid, lane, wave); }
        }
    }
    if (IN(4)) {
        for (int it = G - 1 - bx; it < 256; it += G) sattn_block((LAS float*)(lds + 4096), PS, cache_k, cache_v, MIXS, out + O_KS, out + O_VS, it, tid, lane, wave);
    }
    SEAM(4);
    if (IN(5)) {
        for (int i = gtid; i < MP * 128; i += NT) { const int tok = i >> 7, h = (i >> 4) & 7, ch = i & 15;
            const float l0 = LSE[(size_t)tok * 8 + h], l1 = LSE[(size_t)MP * 8 + (size_t)tok * 8 + h], l2 = LSE[(size_t)2 * MP * 8 + (size_t)tok * 8 + h];
            const float m = fmaxf(l0, fmaxf(l1, l2)); float w0 = fast_exp2(l0 - m), w1 = fast_exp2(l1 - m), w2 = fast_exp2(l2 - m); const float inv = 1.0f / (w0 + w1 + w2); w0 *= inv; w1 *= inv; w2 *= inv;
            const size_t off = (size_t)tok * 1024 + h * 128 + ch * 8;
            const v4u a0 = *(const v4u*)(OP + off), a1 = *(const v4u*)(OP + (size_t)MP * 1024 + off), a2 = *(const v4u*)(OP + (size_t)2 * MP * 1024 + off);
            v4u o;
#pragma unroll
            for (int e = 0; e < 4; ++e) { const float lo_ = w0 * __uint_as_float(a0[e] << 16) + w1 * __uint_as_float(a1[e] << 16) + w2 * __uint_as_float(a2[e] << 16);
                const float hi_ = w0 * __uint_as_float(a0[e] & 0xffff0000u) + w1 * __uint_as_float(a1[e] & 0xffff0000u) + w2 * __uint_as_float(a2[e] & 0xffff0000u);
                o[e] = cvt_pk_bf16(lo_, hi_); }
            *(v4u*)(MIXED + (size_t)tok * DM + h * 128 + ch * 8) = o; }
    }
    SEAM(5);
    if (IN(6)) {
        pg8::Gemm g{MIXED, WOUT, MP, DM, DM}; pg8::StaticOrder S; S.init(MP, DM, G, bx);
        EpiRes E{x_prompt, T1};
        pg8::gemm_phase<EpiRes, pg8::StaticOrder, true, true>(lds, g, S, E);
        skinny_phase(lds, MIXS, WOUT, DM, DM, vb, G, SkRes{x_sample, T1S});
    }
    SEAM(6);
    if (IN(7)) {
        for (int r = gw; r < MP + MS; r += NGW) {
            if (r < MP) ln_row<true>(T1 + (size_t)r * DM, T1 + (size_t)r * DM, HB + (size_t)r * DM, ln1g, ln1b, lane);
            else { const int rs = r - MP; ln_row<true>(T1S + (size_t)rs * DM, T1S + (size_t)rs * DM, HBS + (size_t)rs * DM, ln1g, ln1b, lane); }
        }
    }
    SEAM(7);
    if (IN(8)) {
        pg8::Gemm g{HB, WUP, MP, DFF, DM}; pg8::StaticOrder S; S.init(MP, DFF, G, bx);
        EpiRelu2 E{R};
        pg8::gemm_phase<EpiRelu2, pg8::StaticOrder, true, true>(lds, g, S, E);
        skinny_phase(lds, HBS, WUP, DFF, DM, vb, G, SkRelu2{RS});
    }
    SEAM(8);
    if (IN(9)) {
        pg8::Gemm g{R, WDN, MP, DM, DFF}; pg8::StaticOrder S; S.init(MP, DM, G, bx);
        EpiRes E{T1, out + O_YP};
        pg8::gemm_phase<EpiRes, pg8::StaticOrder, true, true>(lds, g, S, E);
        skinny_phase(lds, RS, WDN, DM, DFF, vb, G, SkRes{T1S, out + O_YS});
    }
    SEAM(9);
    if (IN(10)) {
        for (int r = gw; r < MP + MS; r += NGW) { float* yr = out + (size_t)r * DM;
            ln_row<false>(yr, yr, nullptr, ln2g, ln2b, lane); }
    }
#undef IN
#undef SEAM
}

extern "C" void kernel_launch(void* const* d_in, const int* in_sizes, int n_in, void* d_out, int out_size, void* d_ws, size_t ws_size, hipStream_t stream) {
    static int grid = 0;
    if (grid == 0) {
        if (n_in != 17 || (size_t)out_size != O_END || ws_size < WS_END) { fprintf(stderr, "kernel_launch: unexpected shapes (n_in %d out %d ws %zu)\n", n_in, out_size, ws_size); grid = -1; return; }
        int dev = 0, cus = 0, per_cu = 0;
        hipGetDevice(&dev); hipDeviceGetAttribute(&cus, hipDeviceAttributeMultiprocessorCount, dev);
        if (hipFuncSetAttribute((const void*)fwd_kernel, hipFuncAttributeMaxDynamicSharedMemorySize, LDS_BYTES) != hipSuccess) { fprintf(stderr, "kernel_launch: hipFuncSetAttribute failed\n"); grid = -1; return; }
        if (hipOccupancyMaxActiveBlocksPerMultiprocessor(&per_cu, (const void*)fwd_kernel, 512, LDS_BYTES) != hipSuccess || per_cu < 1) { fprintf(stderr, "kernel_launch: occupancy query gave %d\n", per_cu); per_cu = 1; }
        (void)hipGetLastError();
        grid = cus * 1;
    }
    if (grid < 0) return;
    Args a{};
    for (int i = 0; i < 17; ++i) a.in[i] = (const float*)d_in[i];
    a.out = (float*)d_out; a.ws = (unsigned char*)d_ws;
#ifndef LAUNCH_PROG
#define LAUNCH_PROG {0, N_PHASES}
#endif
    static const int prog[] = LAUNCH_PROG;
    for (unsigned li = 0; li + 1 < sizeof(prog) / sizeof(int); li += 2) {
        a.ph_lo = prog[li]; a.ph_hi = prog[li + 1];
        (void)hipMemsetAsync(d_ws, 0, 65536, stream);
        void* kargs[] = {&a};
        hipError_t e = hipLaunchCooperativeKernel((const void*)fwd_kernel, dim3(grid), dim3(512), kargs, LDS_BYTES, stream);
        if (e != hipSuccess) fprintf(stderr, "cooperative launch failed: %s (grid %d)\n", hipGetErrorString(e), grid);
    }
}
```
